# Optimizing an MI355X kernel written in HIP

```python
import jax, jax.numpy as jnp
from jax import lax
import numpy as np

D_MODEL = 2048
BATCH = 2
SEQ = 4096
DEPTH = 1

POOL_WIDTH = D_MODEL
POOL_WINDOWS = (2, 4, 8, 16)
N_POOL_GROUPS = len(POOL_WINDOWS)
POOL_GROUP_WIDTH = POOL_WIDTH // N_POOL_GROUPS
LRU_WIDTH = D_MODEL
LRU_BLOCK = 256
N_LRU_HEADS = LRU_WIDTH // LRU_BLOCK
CONV_WIDTH = 4
LRU_C = 8.0
N_DIRS = 2
N_BRANCHES = 2
D_FF = 4 * D_MODEL
IN_WIDTH = POOL_WIDTH + 2 * LRU_WIDTH + N_BRANCHES * D_MODEL
DN_ALPHA = (2.0 * DEPTH) ** 0.25
DN_BETA = (8.0 * DEPTH) ** -0.25
LN_EPS = 1e-5

kernel_name = "hybrid_pool_rglru_encoder_block"


def layer_norm(x, g, b):
    xf = x.astype(jnp.float32)
    mu = jnp.mean(xf, axis=-1, keepdims=True)
    xc = xf - mu
    var = jnp.mean(xc * xc, axis=-1, keepdims=True)
    y = xc * lax.rsqrt(var + LN_EPS) * g.astype(jnp.float32) + b.astype(jnp.float32)
    return y.astype(x.dtype)


def multiscale_pool(u, pool_w, pool_scale):
    B, S, P = u.shape
    uf = u.astype(jnp.float32)
    csum = jnp.pad(jnp.cumsum(uf, axis=1), ((0, 0), (1, 0), (0, 0)))
    t = jnp.arange(S)
    outs = []
    for g, w in enumerate(POOL_WINDOWS):
        lo = jnp.clip(t - w // 2, 0, S)
        hi = jnp.clip(t + w // 2, 0, S)
        sl = slice(g * POOL_GROUP_WIDTH, (g + 1) * POOL_GROUP_WIDTH)
        c = csum[:, :, sl]
        mean = (c[:, hi] - c[:, lo]) / (hi - lo).astype(jnp.float32)[None, :, None]
        outs.append(mean - uf[:, :, sl])
    d = jnp.stack(outs, axis=2)
    y = jnp.einsum('bsgi,gio->bsgo', d, pool_w.astype(jnp.float32)).reshape(B, S, P)
    return (y * pool_scale.astype(jnp.float32)).astype(u.dtype)


def centred_depthwise_conv(u, w, b):
    S = u.shape[1]
    left = CONV_WIDTH // 2
    right = CONV_WIDTH - 1 - left
    up = jnp.pad(u, ((0, 0), (left, right), (0, 0)))
    y = b
    for k in range(CONV_WIDTH):
        y = y + up[:, k:k + S, :] * w[k]
    return y


def _lin_combine(p, q):
    a1, b1 = p
    a2, b2 = q
    return a1 * a2, a2 * b1 + b2


def rg_lru(xc, wa, ba, wx, bx, lam, reverse):
    B, S, R = xc.shape
    xf = xc.astype(jnp.float32)
    xh = xf.reshape(B, S, N_LRU_HEADS, LRU_BLOCK)
    r = jax.nn.sigmoid(jnp.einsum('bshi,hio->bsho', xh, wa.astype(jnp.float32)).reshape(B, S, R) + ba.astype(jnp.float32))
    i = jax.nn.sigmoid(jnp.einsum('bshi,hio->bsho', xh, wx.astype(jnp.float32)).reshape(B, S, R) + bx.astype(jnp.float32))
    log_a = -LRU_C * jax.nn.softplus(-lam.astype(jnp.float32)) * r
    a = jnp.exp(log_a)
    inp = jnp.sqrt(-jnp.expm1(2.0 * log_a)) * (i * xf)
    _, h = lax.associative_scan(_lin_combine, (a, inp), axis=1, reverse=reverse)
    return h


def hybrid_mixer(x, w_in, pool_w, pool_scale, conv_w, conv_b, lru_wa, lru_ba, lru_wx, lru_bx,
                 lru_lambda, w_pool_up, w_lru_up, w_out, b_out):
    B, S, D = x.shape
    z = jnp.einsum('bsd,de->bse', x, w_in)
    o1 = POOL_WIDTH
    o2 = o1 + LRU_WIDTH
    o3 = o2 + LRU_WIDTH
    u_pool, u_lru, u_gate, g_logits = z[..., :o1], z[..., o1:o2], z[..., o2:o3], z[..., o3:]
    y_pool = multiscale_pool(u_pool, pool_w, pool_scale)
    xc = centred_depthwise_conv(u_lru, conv_w, conv_b)
    h = (rg_lru(xc, lru_wa[0], lru_ba[0], lru_wx[0], lru_bx[0], lru_lambda[0], False)
         + rg_lru(xc, lru_wa[1], lru_ba[1], lru_wx[1], lru_bx[1], lru_lambda[1], True))
    y_lru = h.astype(x.dtype) * jax.nn.gelu(u_gate)
    g = jax.nn.sigmoid(g_logits.astype(jnp.float32)).astype(x.dtype).reshape(B, S, N_BRANCHES, D)
    m = (g[:, :, 0] * jnp.einsum('bsp,pd->bsd', y_pool, w_pool_up)
         + g[:, :, 1] * jnp.einsum('bsr,rd->bsd', y_lru, w_lru_up))
    return jnp.einsum('bsd,de->bse', m, w_out) + b_out


def sq_relu_mlp(x, w1, b1, w2, b2):
    hdn = jnp.square(jax.nn.relu(jnp.einsum('bsd,df->bsf', x, w1) + b1))
    return jnp.einsum('bsf,fd->bsd', hdn, w2) + b2


def setup_inputs(seed: int = 0) -> dict:
    key = jax.random.key(seed)
    ks = jax.random.split(key, 24)
    f32 = jnp.float32
    L, D, P, R = DEPTH, D_MODEL, POOL_WIDTH, LRU_WIDTH
    nrm = lambda k, shape, s: jax.random.normal(k, shape, f32) * s
    a_base = jax.random.uniform(ks[10], (L, N_DIRS, R), f32, minval=0.9, maxval=0.999)
    s = a_base ** (1.0 / LRU_C)
    lam = jnp.log(s) - jnp.log1p(-s)
    return {
        "x": nrm(ks[0], (BATCH, SEQ, D), 1.0),
        "w_in": nrm(ks[1], (L, D, IN_WIDTH), D ** -0.5),
        "pool_w": nrm(ks[2], (L, N_POOL_GROUPS, POOL_GROUP_WIDTH, POOL_GROUP_WIDTH), POOL_GROUP_WIDTH ** -0.5),
        "pool_scale": 1.0 + nrm(ks[3], (L, P), 0.1),
        "conv_w": nrm(ks[4], (L, CONV_WIDTH, R), CONV_WIDTH ** -0.5),
        "conv_b": nrm(ks[5], (L, R), 0.01),
        "lru_wa": nrm(ks[6], (L, N_DIRS, N_LRU_HEADS, LRU_BLOCK, LRU_BLOCK), LRU_BLOCK ** -0.5),
        "lru_ba": nrm(ks[7], (L, N_DIRS, R), 0.01),
        "lru_wx": nrm(ks[8], (L, N_DIRS, N_LRU_HEADS, LRU_BLOCK, LRU_BLOCK), LRU_BLOCK ** -0.5),
        "lru_bx": nrm(ks[9], (L, N_DIRS, R), 0.01),
        "lru_lambda": lam,
        "w_pool_up": nrm(ks[11], (L, P, D), DN_BETA * P ** -0.5),
        "w_lru_up": nrm(ks[12], (L, R, D), DN_BETA * R ** -0.5),
        "w_out": nrm(ks[13], (L, D, D), DN_BETA * D ** -0.5),
        "b_out": nrm(ks[14], (L, D), 0.01),
        "ln1_g": 1.0 + nrm(ks[15], (L, D), 0.1),
        "ln1_b": nrm(ks[16], (L, D), 0.01),
        "w_ff1": nrm(ks[17], (L, D, D_FF), D ** -0.5),
        "b_ff1": nrm(ks[18], (L, D_FF), 0.01),
        "w_ff2": nrm(ks[19], (L, D_FF, D), DN_BETA * D_FF ** -0.5),
        "b_ff2": nrm(ks[20], (L, D), 0.01),
        "ln2_g": 1.0 + nrm(ks[21], (L, D), 0.1),
        "ln2_b": nrm(ks[22], (L, D), 0.01),
    }


def reference(x, w_in, pool_w, pool_scale, conv_w, conv_b, lru_wa, lru_ba, lru_wx, lru_bx,
              lru_lambda, w_pool_up, w_lru_up, w_out, b_out, ln1_g, ln1_b,
              w_ff1, b_ff1, w_ff2, b_ff2, ln2_g, ln2_b):
    for l in range(DEPTH):
        mix = hybrid_mixer(x, w_in[l], pool_w[l], pool_scale[l], conv_w[l], conv_b[l],
                           lru_wa[l], lru_ba[l], lru_wx[l], lru_bx[l], lru_lambda[l],
                           w_pool_up[l], w_lru_up[l], w_out[l], b_out[l])
        x = layer_norm(DN_ALPHA * x + mix, ln1_g[l], ln1_b[l])
        ff = sq_relu_mlp(x, w_ff1[l], b_ff1[l], w_ff2[l], b_ff2[l])
        x = layer_norm(DN_ALPHA * x + ff, ln2_g[l], ln2_b[l])
    return x
```

```cpp
#include <hip/hip_runtime.h>
#include <hip/hip_cooperative_groups.h>
#include <cstdio>
#include <cstdint>
namespace cg = cooperative_groups;

#ifndef MK_N_LAUNCHES
#define MK_N_LAUNCHES 1
#endif

namespace pg8 {
#define PG8_LAS __attribute__((address_space(3)))
typedef unsigned short bf16_t;
typedef short bf16x8 __attribute__((ext_vector_type(8)));
typedef float f32x4 __attribute__((ext_vector_type(4)));
typedef float f32x2 __attribute__((ext_vector_type(2)));
typedef unsigned u32x4 __attribute__((ext_vector_type(4)));
typedef unsigned u32x2 __attribute__((ext_vector_type(2)));
constexpr int BM = 256, BK = 64, HALF = 128, HTB = HALF * BK * 2, STAGE_BYTES = 8 * HTB, NXCD = 8, WGM = 8;

__host__ __device__ __forceinline__ int lds_byte(int r, int c) { const int st = (r >> 4) * 2 + (c >> 5), rr = r & 15, cc = c & 31, ob = rr * 64 + cc * 2; return st * 1024 + (ob ^ (((ob >> 9) & 1) << 5)); }
__host__ __device__ __forceinline__ void stage_rc(int b, int& R, int& C) { const int st = b / 1024, sb = b % 1024, swz = sb ^ (((sb >> 9) & 1) << 5); R = (st >> 1) * 16 + swz / 64; C = (st & 1) * 32 + (swz % 64) / 2; }
__host__ __device__ __forceinline__ int perm32(int rho) { const int n = rho >> 4, i = rho & 15; return 8 * (i >> 2) + 4 * n + (i & 3); }

struct Unit { int pm, pn; };
struct Gemm { const bf16_t* A; const bf16_t* Bt; int lda, ldb, nt, adiv, astride; };

struct StaticOrder {
    int nM, nN, nwg, G, c;
    __device__ void init(int nM_, int nN_, int G_, int c_) { nM = nM_; nN = nN_; nwg = nM * nN; G = G_; c = c_; }
    __device__ bool next(int i, Unit& u) const {
        const long L = (long)i * G + c; if (L >= nwg) return false;
        int wgid = (int)L; { const int q = nwg / NXCD, r = nwg % NXCD, xcd = wgid % NXCD, off = wgid / NXCD; wgid = (xcd < r ? xcd * (q + 1) : r * (q + 1) + (xcd - r) * q) + off; }
        const int nig = WGM * nN, gid = wgid / nig, fm = gid * WGM, gsz = (nM - fm) < WGM ? (nM - fm) : WGM;
        u.pm = fm + ((wgid % nig) % gsz); u.pn = (wgid % nig) / gsz; return true;
    }
};

__device__ __forceinline__ unsigned cvt_pk_bf16(float lo, float hi) { unsigned r; asm volatile("v_cvt_pk_bf16_f32 %0, %1, %2" : "=v"(r) : "v"(lo), "v"(hi)); return r; }
__device__ __forceinline__ float bf_lo(unsigned w) { return __builtin_bit_cast(float, w << 16); }
__device__ __forceinline__ float bf_hi(unsigned w) { return __builtin_bit_cast(float, w & 0xffff0000u); }
__device__ __forceinline__ float fsigmoid(float v) { return __builtin_amdgcn_rcpf(1.0f + __builtin_amdgcn_exp2f(-1.44269504f * v)); }
__device__ __forceinline__ float gelu_tanh(float v) { const float y = v * (1.0f + 0.044715f * v * v); return v * __builtin_amdgcn_rcpf(1.0f + __builtin_amdgcn_exp2f(-2.30220819f * y)); }
template <int CTRL> __device__ __forceinline__ float dpp(float old, float src) {
    return __builtin_bit_cast(float, __builtin_amdgcn_update_dpp(__builtin_bit_cast(int, old), __builtin_bit_cast(int, src), CTRL, 0xf, 0xf, false));
}
#define EPI_BAR() do { asm volatile("s_waitcnt lgkmcnt(0)" ::: "memory"); __builtin_amdgcn_s_barrier(); asm volatile("" ::: "memory"); } while (0)

typedef f32x4 Acc[2][2][4][2];
constexpr int MT = 8192, DM = 2048;

struct EpiZ {
    static constexpr bool PERM = true, MID = false;
    bf16_t* Z0;
    __device__ __forceinline__ void operator()(Acc& acc, const Unit& u, int wr, int wc, int fr, int fq, PG8_LAS unsigned char*) const {
        const int region = u.pn >> 3;
        bf16_t* base = Z0 + (size_t)region * ((size_t)MT * DM) + (size_t)(u.pm * BM + wr * 64 + fr) * DM + (u.pn & 7) * BM + wc * 32 + 8 * fq;
#pragma unroll
        for (int ai = 0; ai < 2; ++ai)
#pragma unroll
            for (int m = 0; m < 4; ++m) { bf16_t* rowp = base + (size_t)(ai * HALF + m * 16) * DM;
#pragma unroll
                for (int bj = 0; bj < 2; ++bj) { f32x4 v0 = acc[ai][bj][m][0], v1 = acc[ai][bj][m][1];
                    if (region == 2) {
#pragma unroll
                        for (int e = 0; e < 4; ++e) { v0[e] = gelu_tanh(v0[e]); v1[e] = gelu_tanh(v1[e]); }
                    } else if (region >= 3) {
#pragma unroll
                        for (int e = 0; e < 4; ++e) { v0[e] = fsigmoid(v0[e]); v1[e] = fsigmoid(v1[e]); }
                    }
                    u32x4 w; w.x = cvt_pk_bf16(v0[0], v0[1]); w.y = cvt_pk_bf16(v0[2], v0[3]); w.z = cvt_pk_bf16(v1[0], v1[1]); w.w = cvt_pk_bf16(v1[2], v1[3]);
                    *(u32x4*)(rowp + bj * HALF) = w; } }
    }
};
template <int MODE> struct EpiB {
    static constexpr bool PERM = true, MID = false;
    bf16_t* O; int ldc; const float* vec;
    __device__ __forceinline__ void operator()(Acc& acc, const Unit& u, int wr, int wc, int fr, int fq, PG8_LAS unsigned char*) const {
        const int col0 = u.pn * BM + wc * 32 + 8 * fq;
        f32x4 bv[2][2];
#pragma unroll
        for (int bj = 0; bj < 2; ++bj)
#pragma unroll
            for (int n = 0; n < 2; ++n) bv[bj][n] = *(const f32x4*)(vec + col0 + bj * HALF + 4 * n);
        bf16_t* base = O + (size_t)(u.pm * BM + wr * 64 + fr) * ldc + col0;
#pragma unroll
        for (int ai = 0; ai < 2; ++ai)
#pragma unroll
            for (int m = 0; m < 4; ++m) { bf16_t* rowp = base + (size_t)(ai * HALF + m * 16) * ldc;
#pragma unroll
                for (int bj = 0; bj < 2; ++bj) { f32x4 v0, v1;
                    if (MODE == 0) { v0 = acc[ai][bj][m][0] * bv[bj][0]; v1 = acc[ai][bj][m][1] * bv[bj][1]; }
                    else { v0 = acc[ai][bj][m][0] + bv[bj][0]; v1 = acc[ai][bj][m][1] + bv[bj][1];
#pragma unroll
                        for (int e = 0; e < 4; ++e) { const float a = fmaxf(v0[e], 0.f), b = fmaxf(v1[e], 0.f); v0[e] = a * a; v1[e] = b * b; } }
                    u32x4 w; w.x = cvt_pk_bf16(v0[0], v0[1]); w.y = cvt_pk_bf16(v0[2], v0[3]); w.z = cvt_pk_bf16(v1[0], v1[1]); w.w = cvt_pk_bf16(v1[2], v1[3]);
                    *(u32x4*)(rowp + bj * HALF) = w; } }
    }
};
struct EpiMerge {
    static constexpr bool PERM = true, MID = true;
    const bf16_t* GA; const bf16_t* GB; bf16_t* O;
    __device__ __forceinline__ void mid(Acc& acc, const Unit& u, int wr, int wc, int fr, int fq) const {
        const size_t off0 = (size_t)(u.pm * BM + wr * 64 + fr) * DM + u.pn * BM + wc * 32 + 8 * fq;
#pragma unroll
        for (int ai = 0; ai < 2; ++ai)
#pragma unroll
            for (int m = 0; m < 4; ++m) {
#pragma unroll
                for (int bj = 0; bj < 2; ++bj) { const size_t off = off0 + (size_t)(ai * HALF + m * 16) * DM + bj * HALF;
                    const u32x4 a = *(const u32x4*)(GA + off), b = *(const u32x4*)(GB + off);
                    f32x4 r0, r1;
                    r0[0] = bf_lo(a.x) * __builtin_amdgcn_rcpf(bf_lo(b.x)); r0[1] = bf_hi(a.x) * __builtin_amdgcn_rcpf(bf_hi(b.x));
                    r0[2] = bf_lo(a.y) * __builtin_amdgcn_rcpf(bf_lo(b.y)); r0[3] = bf_hi(a.y) * __builtin_amdgcn_rcpf(bf_hi(b.y));
                    r1[0] = bf_lo(a.z) * __builtin_amdgcn_rcpf(bf_lo(b.z)); r1[1] = bf_hi(a.z) * __builtin_amdgcn_rcpf(bf_hi(b.z));
                    r1[2] = bf_lo(a.w) * __builtin_amdgcn_rcpf(bf_lo(b.w)); r1[3] = bf_hi(a.w) * __builtin_amdgcn_rcpf(bf_hi(b.w));
                    acc[ai][bj][m][0] *= r0; acc[ai][bj][m][1] *= r1; }
                asm volatile("" ::: "memory"); }
    }
    __device__ __forceinline__ void operator()(Acc& acc, const Unit& u, int wr, int wc, int fr, int fq, PG8_LAS unsigned char*) const {
        const size_t off0 = (size_t)(u.pm * BM + wr * 64 + fr) * DM + u.pn * BM + wc * 32 + 8 * fq;
#pragma unroll
        for (int ai = 0; ai < 2; ++ai)
#pragma unroll
            for (int m = 0; m < 4; ++m) {
#pragma unroll
                for (int bj = 0; bj < 2; ++bj) { const size_t off = off0 + (size_t)(ai * HALF + m * 16) * DM + bj * HALF;
                    const u32x4 b = *(const u32x4*)(GB + off);
                    const f32x4 v0 = acc[ai][bj][m][0], v1 = acc[ai][bj][m][1];
                    u32x4 w; w.x = cvt_pk_bf16(v0[0] * bf_lo(b.x), v0[1] * bf_hi(b.x)); w.y = cvt_pk_bf16(v0[2] * bf_lo(b.y), v0[3] * bf_hi(b.y));
                    w.z = cvt_pk_bf16(v1[0] * bf_lo(b.z), v1[1] * bf_hi(b.z)); w.w = cvt_pk_bf16(v1[2] * bf_lo(b.w), v1[3] * bf_hi(b.w));
                    *(u32x4*)(O + off) = w; }
                asm volatile("" ::: "memory"); }
    }
};
struct EpiRes {
    static constexpr bool PERM = false, MID = false;
    const float* base; float* out; const float* bias; float alpha;
    __device__ __forceinline__ void operator()(Acc& acc, const Unit& u, int wr, int wc, int fr, int fq, PG8_LAS unsigned char*) const {
        const int col0 = u.pn * BM + wc * 32 + 4 * fq;
        f32x4 bv[2][2];
#pragma unroll
        for (int bj = 0; bj < 2; ++bj)
#pragma unroll
            for (int n = 0; n < 2; ++n) bv[bj][n] = *(const f32x4*)(bias + col0 + bj * HALF + n * 16);
        const size_t off0 = (size_t)(u.pm * BM + wr * 64 + fr) * DM + col0;
#pragma unroll
        for (int ai = 0; ai < 2; ++ai)
#pragma unroll
            for (int m = 0; m < 4; ++m) { const size_t off = off0 + (size_t)(ai * HALF + m * 16) * DM;
#pragma unroll
                for (int bj = 0; bj < 2; ++bj)
#pragma unroll
                    for (int n = 0; n < 2; ++n) { const f32x4 bs = *(const f32x4*)(base + off + bj * HALF + n * 16);
                        *(f32x4*)(out + off + bj * HALF + n * 16) = bs * alpha + acc[ai][bj][m][n] + bv[bj][n]; }
                asm volatile("" ::: "memory"); }
    }
};
#define GATE_SCAN(SHIFT, a, b) do { float ap_, bp_; \
    ap_ = dpp<SHIFT + 1>(1.0f, a); bp_ = dpp<SHIFT + 1>(0.0f, b); b = a * bp_ + b; a = a * ap_; \
    ap_ = dpp<SHIFT + 2>(1.0f, a); bp_ = dpp<SHIFT + 2>(0.0f, b); b = a * bp_ + b; a = a * ap_; \
    ap_ = dpp<SHIFT + 4>(1.0f, a); bp_ = dpp<SHIFT + 4>(0.0f, b); b = a * bp_ + b; a = a * ap_; \
    ap_ = dpp<SHIFT + 8>(1.0f, a); bp_ = dpp<SHIFT + 8>(0.0f, b); b = a * bp_ + b; a = a * ap_; } while (0)
template <int PASS> struct EpiGate {
    static constexpr bool PERM = false, MID = false;
    const bf16_t* XC; const bf16_t* GG; bf16_t* YY; const float* BA; const float* BX; const float* KC; f32x2* AGG;
    __device__ __forceinline__ void operator()(Acc& acc, const Unit& u, int wr, int wc, int fr, int fq, PG8_LAS unsigned char* ldsx) const {
        const int tid = (wr * 4 + wc) * 64 + fq * 16 + fr;
        const int chb = u.pn * 64, cl = wc * 16 + fq * 4, ch0 = chb + cl;
        PG8_LAS float* GS = (PG8_LAS float*)ldsx;
        if (PASS == 2) {
            const int s = tid >> 7, d = (tid >> 6) & 1, c = tid & 63;
            const int sg = u.pm * 4 + s, b0 = sg & ~63;
            const f32x2* ag = AGG + (size_t)d * DM + chb + c;
            float cy = 0.f;
            if (d == 0) { for (int p = b0; p < sg; ++p) { const f32x2 ah = ag[(size_t)p * (2 * DM)]; cy = ah.x * cy + ah.y; } }
            else { for (int p = b0 + 63; p > sg; --p) { const f32x2 ah = ag[(size_t)p * (2 * DM)]; cy = ah.x * cy + ah.y; } }
            GS[tid] = cy;
            EPI_BAR();
        }
        const unsigned rbase = (unsigned)((u.pm * BM + wr * 64 + fr) * DM + ch0);
#define GATE_ELEM(ai, d) do { \
            int cho_ = (d) * DM + ch0; asm volatile("" : "+v"(cho_)); \
            const f32x4 ba_ = *(const f32x4*)(BA + cho_), bx_ = *(const f32x4*)(BX + cho_), kc_ = *(const f32x4*)(KC + cho_); \
            _Pragma("unroll") for (int m = 0; m < 4; ++m) { \
                unsigned xoff = rbase + (unsigned)(((ai) * HALF + m * 16) * DM); asm volatile("" : "+v"(xoff)); \
                const u32x2 xw = *(const u32x2*)(XC + xoff); \
                f32x4 xv; xv[0] = bf_lo(xw.x); xv[1] = bf_hi(xw.x); xv[2] = bf_lo(xw.y); xv[3] = bf_hi(xw.y); \
                _Pragma("unroll") for (int e = 0; e < 4; ++e) { \
                    const float r = fsigmoid(acc[ai][d][m][0][e] + ba_[e]); \
                    const float ig = fsigmoid(acc[ai][d][m][1][e] + bx_[e]); \
                    const float a = __builtin_amdgcn_exp2f(kc_[e] * r); \
                    const float sq = __builtin_amdgcn_sqrtf(fmaxf(1.0f - a * a, 0.f)); \
                    acc[ai][d][m][0][e] = a; acc[ai][d][m][1][e] = sq * (ig * xv[e]); } \
                asm volatile("" ::: "memory"); __builtin_amdgcn_sched_barrier(0); } } while (0)
#pragma unroll
        for (int ai = 0; ai < 2; ++ai) {
            const int s = 2 * ai + wr;
            f32x4 cf = (f32x4){0.f, 0.f, 0.f, 0.f}, cb = cf, Af = (f32x4){1.f, 1.f, 1.f, 1.f}, Ab = Af;
            GATE_ELEM(ai, 0);
            if (PASS == 2) cf = *(const PG8_LAS f32x4*)(GS + (s * 2 + 0) * 64 + cl);
#pragma unroll
            for (int m = 0; m < 4; ++m) {
#pragma unroll
                for (int e = 0; e < 4; ++e) {
                    float a = acc[ai][0][m][0][e], b = acc[ai][0][m][1][e];
                    GATE_SCAN(0x110, a, b);
                    const float h = a * cf[e] + b;
                    acc[ai][0][m][1][e] = h; cf[e] = dpp<0x15F>(0.f, h);
                    if (PASS == 1) Af[e] *= dpp<0x15F>(0.f, a);
                }
                __builtin_amdgcn_sched_barrier(0);
            }
            GATE_ELEM(ai, 1);
            if (PASS == 2) cb = *(const PG8_LAS f32x4*)(GS + (s * 2 + 1) * 64 + cl);
#pragma unroll
            for (int m = 3; m >= 0; --m) {
                f32x4 hb;
#pragma unroll
                for (int e = 0; e < 4; ++e) {
                    float a = acc[ai][1][m][0][e], b = acc[ai][1][m][1][e];
                    GATE_SCAN(0x100, a, b);
                    const float h = a * cb[e] + b;
                    hb[e] = h; cb[e] = dpp<0x150>(0.f, h);
                    if (PASS == 1) Ab[e] *= dpp<0x150>(0.f, a);
                }
                if (PASS == 2) {
                    unsigned goff = rbase + (unsigned)((ai * HALF + m * 16) * DM); asm volatile("" : "+v"(goff));
                    const unsigned yoff = 2u * goff - (unsigned)ch0 + (unsigned)DM;
                    const u32x2 gw = *(const u32x2*)(GG + goff);
                    f32x4 gv; gv[0] = bf_lo(gw.x); gv[1] = bf_hi(gw.x); gv[2] = bf_lo(gw.y); gv[3] = bf_hi(gw.y);
                    const f32x4 y = (acc[ai][0][m][1] + hb) * gv;
                    u32x2 w; w.x = cvt_pk_bf16(y[0], y[1]); w.y = cvt_pk_bf16(y[2], y[3]);
                    *(u32x2*)(YY + yoff) = w;
                }
                asm volatile("" ::: "memory"); __builtin_amdgcn_sched_barrier(0);
            }
            if (PASS == 1) {
                f32x2* ag = AGG + (size_t)(u.pm * 4 + s) * (2 * DM) + ch0;
                if (fr == 15) { *(f32x4*)(ag) = (f32x4){Af[0], cf[0], Af[1], cf[1]}; *(f32x4*)(ag + 2) = (f32x4){Af[2], cf[2], Af[3], cf[3]}; }
                if (fr == 0) { *(f32x4*)(ag + DM) = (f32x4){Ab[0], cb[0], Ab[1], cb[1]}; *(f32x4*)(ag + DM + 2) = (f32x4){Ab[2], cb[2], Ab[3], cb[3]}; }
            }
        }
    }
};

template <class Epi>
__device__ __forceinline__ void gemm_phase(PG8_LAS unsigned char* lds, const Gemm g, const StaticOrder& S, const Epi& E) {
    const int tid = threadIdx.x, wid = __builtin_amdgcn_readfirstlane(tid >> 6), lane = tid & 63, wr = wid >> 2, wc = wid & 3, fr = lane & 15, fq = lane >> 4;
    const int nt = g.nt;
    unsigned voffA[2], voffB[2];
#pragma unroll
    for (int i = 0; i < 2; ++i) { int R, C; stage_rc(tid * 16 + i * 8192, R, C); const int Rb = Epi::PERM ? ((R & ~31) + perm32(R & 31)) : R;
        voffA[i] = (unsigned)(R * g.lda + C) * 2u; voffB[i] = (unsigned)(Rb * g.ldb + C) * 2u; }
    const size_t kstep = (size_t)(BK * 2);
    const size_t hstepA = (size_t)HALF * g.lda * 2, hstepB = (size_t)HALF * g.ldb * 2;
    const unsigned ldsw = (unsigned)wid * 1024u;
    const int aoff = lds_byte(wr * 64 + fr, fq * 8), boff = lds_byte(wc * 32 + fr, fq * 8);
    PG8_LAS unsigned char* ldsx = lds + STAGE_BYTES;
#define PG8_UA(u) ((const char*)g.A + ((size_t)(u).pm * BM * g.lda + (size_t)((u).pn / g.adiv) * g.astride) * 2)
#define PG8_UB(u) ((const char*)g.Bt + (size_t)(u).pn * BM * g.ldb * 2)
#define PG8_SA(b, h) (((b) * 2 + (h)) * HTB)
#define PG8_SB(b, h) ((4 + (b) * 2 + (h)) * HTB)
#define PG8_STAGE(bufoff, gbase, voff) do { _Pragma("unroll") for (int _i = 0; _i < 2; ++_i) \
        __builtin_amdgcn_global_load_lds((const unsigned*)((const char*)(gbase) + (voff)[_i]), (PG8_LAS unsigned*)(lds + (bufoff) + ldsw + _i * 8192), 16, 0, 0); } while (0)
#define PG8_LDA(dst, b, h) do { _Pragma("unroll") for (int m = 0; m < 4; ++m) _Pragma("unroll") for (int k = 0; k < 2; ++k) dst[m][k] = *(const PG8_LAS bf16x8*)(lds + PG8_SA(b, h) + aoff + m * 2048 + k * 1024); } while (0)
#define PG8_LDB(dst, b, h) do { _Pragma("unroll") for (int n = 0; n < 2; ++n) _Pragma("unroll") for (int k = 0; k < 2; ++k) dst[n][k] = *(const PG8_LAS bf16x8*)(lds + PG8_SB(b, h) + boff + n * 2048 + k * 1024); } while (0)
#define PG8_MMA(ai, bj, At, Bt) do { __builtin_amdgcn_s_setprio(1); _Pragma("unroll") for (int m = 0; m < 4; ++m) _Pragma("unroll") for (int n = 0; n < 2; ++n) _Pragma("unroll") for (int k = 0; k < 2; ++k) \
        acc[ai][bj][m][n] = __builtin_amdgcn_mfma_f32_16x16x32_bf16(Bt[n][k], At[m][k], acc[ai][bj][m][n], 0, 0, 0); __builtin_amdgcn_s_setprio(0); } while (0)
#define PG8_WAIT_V(n) asm volatile("s_waitcnt vmcnt(" #n ")" ::: "memory")
#define PG8_WAIT_L(n) asm volatile("s_waitcnt lgkmcnt(" #n ")" ::: "memory")
#define PG8_BAR __builtin_amdgcn_s_barrier()
#define PG8_SCHED __builtin_amdgcn_sched_barrier(0)
    Unit cur, nxt; int ui = 0;
    if (!S.next(0, cur)) return;
    Acc acc;
#pragma unroll
    for (int a = 0; a < 2; ++a)
#pragma unroll
        for (int b = 0; b < 2; ++b)
#pragma unroll
            for (int m = 0; m < 4; ++m)
#pragma unroll
                for (int n = 0; n < 2; ++n) acc[a][b][m][n] = (f32x4){0.f, 0.f, 0.f, 0.f};
    bf16x8 At[4][2], B0[2][2], B1[2][2];
    const char* cA = PG8_UA(cur); const char* cB = PG8_UB(cur);
    PG8_STAGE(PG8_SB(0, 0), cB, voffB); PG8_STAGE(PG8_SB(0, 1), cB + hstepB, voffB); PG8_STAGE(PG8_SA(0, 0), cA, voffA); PG8_STAGE(PG8_SA(0, 1), cA + hstepA, voffA);
    if (wr == 1) PG8_BAR;
    PG8_WAIT_V(2); PG8_BAR;
    PG8_STAGE(PG8_SB(1, 0), cB + kstep, voffB); PG8_STAGE(PG8_SA(1, 0), cA + kstep, voffA); PG8_STAGE(PG8_SB(1, 1), cB + hstepB + kstep, voffB);
    PG8_WAIT_V(6); PG8_BAR;
    for (;;) {
        const bool has_next = S.next(ui + 1, nxt);
        const char* nA = has_next ? PG8_UA(nxt) : cA; const char* nB = has_next ? PG8_UB(nxt) : cB;
        for (int t = 0; t < nt; t += 2) {
            if constexpr (Epi::MID) { if (t == (nt >> 1)) { int fr_ = fr, fq_ = fq; asm volatile("" : "+v"(fr_), "+v"(fq_)); E.mid(acc, cur, wr, wc, fr_, fq_); } }
            const bool last = (t == nt - 2);
            const char* a1 = cA + (size_t)(t + 1) * kstep;
            const char* a2 = last ? nA : cA + (size_t)(t + 2) * kstep; const char* b2 = last ? nB : cB + (size_t)(t + 2) * kstep;
            const char* a3 = a2 + kstep; const char* b3 = b2 + kstep;
            PG8_LDB(B0, 0, 0); PG8_LDB(B1, 0, 1); PG8_SCHED; PG8_LDA(At, 0, 0); PG8_STAGE(PG8_SA(1, 1), a1 + hstepA, voffA);
            PG8_WAIT_V(8); PG8_WAIT_L(0); PG8_BAR; PG8_MMA(0, 0, At, B0); PG8_MMA(0, 1, At, B1); PG8_BAR; PG8_SCHED;
            PG8_LDA(At, 0, 1); PG8_STAGE(PG8_SB(0, 0), b2, voffB); PG8_STAGE(PG8_SB(0, 1), b2 + hstepB, voffB); PG8_STAGE(PG8_SA(0, 0), a2, voffA);
            PG8_WAIT_V(8); PG8_WAIT_L(0); PG8_BAR; PG8_MMA(1, 0, At, B0); PG8_MMA(1, 1, At, B1); PG8_BAR; PG8_SCHED;
            PG8_LDB(B0, 1, 0); PG8_LDB(B1, 1, 1); PG8_SCHED; PG8_LDA(At, 1, 0); PG8_STAGE(PG8_SA(0, 1), a2 + hstepA, voffA);
            PG8_WAIT_V(8); PG8_WAIT_L(0); PG8_BAR; PG8_MMA(0, 0, At, B0); PG8_MMA(0, 1, At, B1); PG8_BAR; PG8_SCHED;
            PG8_LDA(At, 1, 1); PG8_STAGE(PG8_SB(1, 0), b3, voffB); PG8_STAGE(PG8_SB(1, 1), b3 + hstepB, voffB); PG8_STAGE(PG8_SA(1, 0), a3, voffA);
            PG8_WAIT_V(8); PG8_WAIT_L(0); PG8_BAR; PG8_MMA(1, 0, At, B0); PG8_MMA(1, 1, At, B1); PG8_BAR; PG8_SCHED;
        }
        if (wr == 0) PG8_BAR;
        asm volatile("" ::: "memory"); __builtin_amdgcn_sched_barrier(0);
        { int fr_ = fr, fq_ = fq; asm volatile("" : "+v"(fr_), "+v"(fq_)); E(acc, cur, wr, wc, fr_, fq_, ldsx); }
        if (!has_next) break;
#pragma unroll
        for (int a = 0; a < 2; ++a)
#pragma unroll
            for (int b = 0; b < 2; ++b)
#pragma unroll
                for (int m = 0; m < 4; ++m)
#pragma unroll
                    for (int n = 0; n < 2; ++n) acc[a][b][m][n] = (f32x4){0.f, 0.f, 0.f, 0.f};
        cur = nxt; cA = nA; cB = nB; ++ui;
        if (wr == 1) PG8_BAR;
    }
    PG8_WAIT_V(0);
    PG8_BAR;
#undef PG8_UA
#undef PG8_UB
#undef PG8_SA
#undef PG8_SB
#undef PG8_STAGE
#undef PG8_LDA
#undef PG8_LDB
#undef PG8_MMA
#undef PG8_WAIT_V
#undef PG8_WAIT_L
#undef PG8_BAR
#undef PG8_SCHED
}
}

using pg8::bf16_t; using pg8::f32x4; using pg8::f32x2; using pg8::u32x4; using pg8::u32x2;
#define LAS __attribute__((address_space(3)))
constexpr int MT = 8192, DM = 2048, SEQ = 4096, NIN = 10240, FF = 8192;
constexpr float DN_ALPHA = 1.189207115002721f, LN_EPS = 1e-5f;
constexpr size_t MiB = 1u << 20;
constexpr size_t WS_KC = 0, WS_AGG = 296 * MiB;
constexpr size_t WS_WIN = 2 * MiB, WS_XB = 42 * MiB, WS_POOLT = 74 * MiB, WS_WG = 76 * MiB, WS_WUP = 80 * MiB, WS_WOUT = 96 * MiB;
constexpr size_t WS_Z = 104 * MiB;
constexpr size_t WS_UP = WS_Z, WS_UL = WS_Z + 32 * MiB, WS_GG = WS_Z + 64 * MiB, WS_GA = WS_Z + 96 * MiB, WS_GB = WS_Z + 128 * MiB;
constexpr size_t WS_D = 264 * MiB, WS_XC = 34 * MiB, WS_W1 = 2 * MiB;
constexpr size_t WS_YY = 104 * MiB, WS_MB = 264 * MiB, WS_V1 = 168 * MiB;
constexpr size_t WS_X1 = 232 * MiB, WS_X1B = 34 * MiB, WS_W2 = 66 * MiB, WS_H = 104 * MiB, WS_V2 = 2 * MiB;
constexpr size_t WS_END = 320 * MiB;
constexpr int LDS_BYTES = 147456;
constexpr int NPHASE = 11;

__device__ __forceinline__ float wave_sum(float v) {
#pragma unroll
    for (int o = 1; o < 64; o <<= 1) v += __shfl_xor(v, o);
    return v;
}
__device__ __forceinline__ void transpose_item(const float* S, int lds_, bf16_t* Dst, int ldd, int k0, int n0, int mode, int dgoff, LAS float* scr, int lane) {
    {
        const int kr = lane >> 4, nc = (lane & 15) * 4;
        const float* sp = S + (size_t)(k0 + kr) * lds_ + n0 + nc;
#pragma unroll
        for (int i = 0; i < 16; ++i) { const f32x4 v = *(const f32x4*)(sp + (size_t)(4 * i) * lds_); LAS float* d = scr + (4 * i + kr) * 65 + nc; d[0] = v[0]; d[1] = v[1]; d[2] = v[2]; d[3] = v[3]; }
    }
    asm volatile("s_waitcnt lgkmcnt(0)" ::: "memory");
#pragma unroll
    for (int j = 0; j < 8; ++j) {
        const int q = j * 64 + lane, n = q >> 3, c = q & 7;
        const LAS float* s = scr + (8 * c) * 65 + n;
        u32x4 o; o.x = pg8::cvt_pk_bf16(s[0], s[65]); o.y = pg8::cvt_pk_bf16(s[130], s[195]); o.z = pg8::cvt_pk_bf16(s[260], s[325]); o.w = pg8::cvt_pk_bf16(s[390], s[455]);
        const int nn = n0 + n;
        const int row = mode == 0 ? nn : ((nn >> 6) * 256 + dgoff + ((nn & 63) >> 4) * 32 + (nn & 15));
        *(u32x4*)(Dst + (size_t)row * ldd + k0 + 8 * c) = o;
    }
    asm volatile("s_waitcnt lgkmcnt(0)" ::: "memory");
}
__device__ __forceinline__ void transpose_matrix(const float* S, int K, int N, bf16_t* Dst, int ldd, int it, LAS float* scr, int lane) {
    const int nblk = N >> 6, kb = it / nblk, nb = it % nblk;
    transpose_item(S, N, Dst, ldd, kb * 64, nb * 64, 0, 0, scr, lane);
}

struct Args {
    const float *x, *w_in, *pool_w, *pool_scale, *conv_w, *conv_b, *lru_wa, *lru_ba, *lru_wx, *lru_bx, *lru_lambda, *w_pool_up, *w_lru_up, *w_out, *b_out,
        *ln1_g, *ln1_b, *w_ff1, *b_ff1, *w_ff2, *b_ff2, *ln2_g, *ln2_b;
    float* out; unsigned char* ws; int ph_lo, ph_hi;
};

__device__ __forceinline__ void ln_rows(const float* V, const float* g, const float* b, float* outf, bf16_t* outb, int gw, int NGW, int lane) {
    for (int row = gw; row < MT; row += NGW) {
        const f32x4* vr = (const f32x4*)(V + (size_t)row * DM) + lane;
        f32x4 v[8]; float s = 0.f;
#pragma unroll
        for (int j = 0; j < 8; ++j) { v[j] = vr[64 * j]; s += (v[j][0] + v[j][1]) + (v[j][2] + v[j][3]); }
        const float mean = wave_sum(s) * (1.f / DM); float s2 = 0.f;
#pragma unroll
        for (int j = 0; j < 8; ++j) { v[j] = v[j] - mean; s2 += (v[j][0] * v[j][0] + v[j][1] * v[j][1]) + (v[j][2] * v[j][2] + v[j][3] * v[j][3]); }
        const float rstd = 1.0f / sqrtf(wave_sum(s2) * (1.f / DM) + LN_EPS);
#pragma unroll
        for (int j = 0; j < 8; ++j) {
            const f32x4 gg = *((const f32x4*)g + lane + 64 * j), bb = *((const f32x4*)b + lane + 64 * j);
            const f32x4 y = v[j] * rstd * gg + bb;
            *((f32x4*)(outf + (size_t)row * DM) + lane + 64 * j) = y;
            if (outb) { u32x2 w; w.x = pg8::cvt_pk_bf16(y[0], y[1]); w.y = pg8::cvt_pk_bf16(y[2], y[3]); *((u32x2*)(outb + (size_t)row * DM) + lane + 64 * j) = w; }
        }
    }
}

__global__ void __launch_bounds__(512, 2) fwd_kernel(Args a) {
    extern __shared__ __attribute__((aligned(16))) unsigned char lds_raw[];
    LAS unsigned char* lds = (LAS unsigned char*)lds_raw;
    const int G = gridDim.x, bx = blockIdx.x;
#define THREAD_IDS() int tid = threadIdx.x; asm volatile("" : "+v"(tid)); const int lane = tid & 63, wave = __builtin_amdgcn_readfirstlane(tid >> 6); \
    const int gw = bx * 8 + wave, NGW = G * 8, gt = bx * 512 + tid, NT = G * 512; LAS float* scr = (LAS float*)(lds + wave * 16640); (void)lane; (void)gw; (void)NGW; (void)gt; (void)NT; (void)scr
    unsigned char* ws = a.ws;
    bf16_t* WinT = (bf16_t*)(ws + WS_WIN); bf16_t* XB = (bf16_t*)(ws + WS_XB); bf16_t* PoolT = (bf16_t*)(ws + WS_POOLT); bf16_t* WgT = (bf16_t*)(ws + WS_WG);
    bf16_t* WupT = (bf16_t*)(ws + WS_WUP); bf16_t* WoutT = (bf16_t*)(ws + WS_WOUT); bf16_t* W1T = (bf16_t*)(ws + WS_W1); bf16_t* W2T = (bf16_t*)(ws + WS_W2);
    bf16_t* Z0 = (bf16_t*)(ws + WS_Z); bf16_t* UP = (bf16_t*)(ws + WS_UP); bf16_t* UL = (bf16_t*)(ws + WS_UL); bf16_t* GGb = (bf16_t*)(ws + WS_GG);
    bf16_t* GAb = (bf16_t*)(ws + WS_GA); bf16_t* GBb = (bf16_t*)(ws + WS_GB);
    bf16_t* Db = (bf16_t*)(ws + WS_D); bf16_t* XCb = (bf16_t*)(ws + WS_XC); bf16_t* YY = (bf16_t*)(ws + WS_YY); bf16_t* Mb = (bf16_t*)(ws + WS_MB);
    float* V1 = (float*)(ws + WS_V1); float* X1 = (float*)(ws + WS_X1); bf16_t* X1B = (bf16_t*)(ws + WS_X1B); bf16_t* Hb = (bf16_t*)(ws + WS_H); float* V2 = (float*)(ws + WS_V2);
    float* KC = (float*)(ws + WS_KC); f32x2* AGG = (f32x2*)(ws + WS_AGG);
    const int lo = a.ph_lo, hi = a.ph_hi;
#ifndef PH_MASK
#define PH_MASK 0x7ff
#endif
#define IN(k) (((PH_MASK >> (k)) & 1) && lo <= (k) && (k) < hi)
#define SEAM(k) do { if (IN(k) && IN((k) + 1)) cg::this_grid().sync(); } while (0)

    if (IN(0)) {
        THREAD_IDS();
        constexpr int I_IN = 32 * 160, I_POOL = 4 * 64, I_G = 32 * 16, I_UP = 1024, I_OUT = 1024;
        constexpr int NITEMS = I_IN + I_POOL + I_G + 2 * I_UP + I_OUT;
        for (int it = gw; it < NITEMS; it += NGW) {
            int r = it;
            if (r < I_IN) { transpose_matrix(a.w_in, DM, NIN, WinT, DM, r, scr, lane); continue; } r -= I_IN;
            if (r < I_POOL) { const int g = r >> 6; transpose_matrix(a.pool_w + (size_t)g * 512 * 512, 512, 512, PoolT + (size_t)g * 512 * 512, 512, r & 63, scr, lane); continue; } r -= I_POOL;
            if (r < I_G) { const int mat = r >> 4, sub = r & 15, h = mat & 7, gate = (mat >> 3) & 1, dir = mat >> 4;
                const float* S = (gate ? a.lru_wx : a.lru_wa) + (size_t)(dir * 8 + h) * 256 * 256;
                transpose_item(S, 256, WgT + (size_t)h * 4 * 256 * 256, 256, (sub >> 2) * 64, (sub & 3) * 64, 1, 128 * dir + 16 * gate, scr, lane); continue; } r -= I_G;
            if (r < I_UP) { transpose_matrix(a.w_pool_up, DM, DM, WupT, 2 * DM, r, scr, lane); continue; } r -= I_UP;
            if (r < I_UP) { transpose_matrix(a.w_lru_up, DM, DM, WupT + DM, 2 * DM, r, scr, lane); continue; } r -= I_UP;
            transpose_matrix(a.w_out, DM, DM, WoutT, DM, r, scr, lane);
        }
        for (int i = gt; i < MT * DM / 8; i += NT) {
            const f32x4 v0 = *((const f32x4*)a.x + 2 * (size_t)i), v1 = *((const f32x4*)a.x + 2 * (size_t)i + 1);
            u32x4 w; w.x = pg8::cvt_pk_bf16(v0[0], v0[1]); w.y = pg8::cvt_pk_bf16(v0[2], v0[3]); w.z = pg8::cvt_pk_bf16(v1[0], v1[1]); w.w = pg8::cvt_pk_bf16(v1[2], v1[3]);
            *((u32x4*)XB + i) = w;
        }
        if (gt < 2 * DM) KC[gt] = -8.0f * 1.44269504f * log1pf(expf(-a.lru_lambda[gt]));
    }
    SEAM(0);
    if (IN(1)) {
        pg8::Gemm g{XB, WinT, DM, DM, DM / 64, 1, 0}; pg8::StaticOrder S; S.init(32, NIN / 256, G, bx);
        pg8::EpiZ E{Z0};
        pg8::gemm_phase<pg8::EpiZ>(lds, g, S, E);
    }
    SEAM(1);
    if (IN(2)) {
        THREAD_IDS();
        for (int item = gt; item < 512 * 512; item += NT) {
            const int chunk = item & 511, run = item >> 9;
            const int row0 = run * 16, t0 = row0 & (SEQ - 1), rowb = row0 - t0;
            if (chunk < 256) {
                const int c0 = chunk * 8, h = 1 << (chunk >> 6);
                const bf16_t* U = UP + (size_t)rowb * DM + c0;
                float sum[8];
#pragma unroll
                for (int e = 0; e < 8; ++e) sum[e] = 0.f;
                for (int s = t0 - h; s < t0 + h; ++s) if (s >= 0 && s < SEQ) { const u32x4 w = *(const u32x4*)(U + (size_t)s * DM);
                    sum[0] += pg8::bf_lo(w.x); sum[1] += pg8::bf_hi(w.x); sum[2] += pg8::bf_lo(w.y); sum[3] += pg8::bf_hi(w.y); sum[4] += pg8::bf_lo(w.z); sum[5] += pg8::bf_hi(w.z); sum[6] += pg8::bf_lo(w.w); sum[7] += pg8::bf_hi(w.w); }
                for (int i = 0; i < 16; ++i) {
                    const int t = t0 + i; const int lo_ = t - h < 0 ? 0 : t - h, hi_ = t + h > SEQ ? SEQ : t + h;
                    const float inv = 1.0f / (float)(hi_ - lo_);
                    const u32x4 w = *(const u32x4*)(U + (size_t)t * DM);
                    u32x4 o;
                    o.x = pg8::cvt_pk_bf16(sum[0] * inv - pg8::bf_lo(w.x), sum[1] * inv - pg8::bf_hi(w.x)); o.y = pg8::cvt_pk_bf16(sum[2] * inv - pg8::bf_lo(w.y), sum[3] * inv - pg8::bf_hi(w.y));
                    o.z = pg8::cvt_pk_bf16(sum[4] * inv - pg8::bf_lo(w.z), sum[5] * inv - pg8::bf_hi(w.z)); o.w = pg8::cvt_pk_bf16(sum[6] * inv - pg8::bf_lo(w.w), sum[7] * inv - pg8::bf_hi(w.w));
                    *(u32x4*)(Db + (size_t)(rowb + t) * DM + c0) = o;
                    if (t + h < SEQ) { const u32x4 q = *(const u32x4*)(U + (size_t)(t + h) * DM);
                        sum[0] += pg8::bf_lo(q.x); sum[1] += pg8::bf_hi(q.x); sum[2] += pg8::bf_lo(q.y); sum[3] += pg8::bf_hi(q.y); sum[4] += pg8::bf_lo(q.z); sum[5] += pg8::bf_hi(q.z); sum[6] += pg8::bf_lo(q.w); sum[7] += pg8::bf_hi(q.w); }
                    if (t - h >= 0) { const u32x4 q = *(const u32x4*)(U + (size_t)(t - h) * DM);
                        sum[0] -= pg8::bf_lo(q.x); sum[1] -= pg8::bf_hi(q.x); sum[2] -= pg8::bf_lo(q.y); sum[3] -= pg8::bf_hi(q.y); sum[4] -= pg8::bf_lo(q.z); sum[5] -= pg8::bf_hi(q.z); sum[6] -= pg8::bf_lo(q.w); sum[7] -= pg8::bf_hi(q.w); }
                }
            } else {
                const int c0 = (chunk - 256) * 8;
                const bf16_t* U = UL + (size_t)rowb * DM + c0;
                f32x4 w0[4], w1[4];
#pragma unroll
                for (int k = 0; k < 4; ++k) { w0[k] = *(const f32x4*)(a.conv_w + k * DM + c0); w1[k] = *(const f32x4*)(a.conv_w + k * DM + c0 + 4); }
                const f32x4 b0 = *(const f32x4*)(a.conv_b + c0), b1 = *(const f32x4*)(a.conv_b + c0 + 4);
                const u32x4 zz = (u32x4){0u, 0u, 0u, 0u};
                u32x4 r0 = (t0 - 2 >= 0) ? *(const u32x4*)(U + (size_t)(t0 - 2) * DM) : zz;
                u32x4 r1 = (t0 - 1 >= 0) ? *(const u32x4*)(U + (size_t)(t0 - 1) * DM) : zz;
                u32x4 r2 = *(const u32x4*)(U + (size_t)t0 * DM);
                for (int i = 0; i < 16; ++i) {
                    const int t = t0 + i;
                    const u32x4 r3 = (t + 1 < SEQ) ? *(const u32x4*)(U + (size_t)(t + 1) * DM) : zz;
                    f32x4 y0 = b0, y1 = b1;
#define CONV_TAP(rk, k) do { y0 += (f32x4){pg8::bf_lo(rk.x), pg8::bf_hi(rk.x), pg8::bf_lo(rk.y), pg8::bf_hi(rk.y)} * w0[k]; y1 += (f32x4){pg8::bf_lo(rk.z), pg8::bf_hi(rk.z), pg8::bf_lo(rk.w), pg8::bf_hi(rk.w)} * w1[k]; } while (0)
                    CONV_TAP(r0, 0); CONV_TAP(r1, 1); CONV_TAP(r2, 2); CONV_TAP(r3, 3);
#undef CONV_TAP
                    u32x4 o; o.x = pg8::cvt_pk_bf16(y0[0], y0[1]); o.y = pg8::cvt_pk_bf16(y0[2], y0[3]); o.z = pg8::cvt_pk_bf16(y1[0], y1[1]); o.w = pg8::cvt_pk_bf16(y1[2], y1[3]);
                    *(u32x4*)(XCb + (size_t)(rowb + t) * DM + c0) = o;
                    r0 = r1; r1 = r2; r2 = r3;
                }
            }
        }
        for (int it = gw; it < 32 * 128; it += NGW) transpose_matrix(a.w_ff1, DM, FF, W1T, DM, it, scr, lane);
    }
    SEAM(2);
    if (IN(3)) {
        { pg8::Gemm g{Db, PoolT, DM, 512, 8, 2, 512}; pg8::StaticOrder S; S.init(32, 8, G, bx);
          pg8::EpiB<0> E{YY, 2 * DM, a.pool_scale};
          pg8::gemm_phase<pg8::EpiB<0>>(lds, g, S, E); }
        { pg8::Gemm g{XCb, WgT, DM, 256, 4, 4, 256}; pg8::StaticOrder S; S.init(32, 32, G, bx);
          pg8::EpiGate<1> E{XCb, GGb, YY, a.lru_ba, a.lru_bx, KC, AGG};
          pg8::gemm_phase<pg8::EpiGate<1>>(lds, g, S, E); }
    }
    SEAM(3);
    if (IN(4)) {
        pg8::Gemm g{XCb, WgT, DM, 256, 4, 4, 256}; pg8::StaticOrder S; S.init(32, 32, G, bx);
        pg8::EpiGate<2> E{XCb, GGb, YY, a.lru_ba, a.lru_bx, KC, AGG};
        pg8::gemm_phase<pg8::EpiGate<2>>(lds, g, S, E);
    }
    SEAM(4);
    if (IN(5)) {
        pg8::Gemm g{YY, WupT, 2 * DM, 2 * DM, 2 * DM / 64, 1, 0}; pg8::StaticOrder S; S.init(32, 8, G, bx);
        pg8::EpiMerge E{GAb, GBb, Mb};
        pg8::gemm_phase<pg8::EpiMerge>(lds, g, S, E);
    }
    SEAM(5);
    if (IN(6)) {
        pg8::Gemm g{Mb, WoutT, DM, DM, DM / 64, 1, 0}; pg8::StaticOrder S; S.init(32, 8, G, bx);
        pg8::EpiRes E{a.x, V1, a.b_out, DN_ALPHA};
        pg8::gemm_phase<pg8::EpiRes>(lds, g, S, E);
    }
    SEAM(6);
    if (IN(7)) {
        THREAD_IDS();
        ln_rows(V1, a.ln1_g, a.ln1_b, X1, X1B, gw, NGW, lane);
        for (int it = gw; it < 128 * 32; it += NGW) transpose_matrix(a.w_ff2, FF, DM, W2T, FF, it, scr, lane);
    }
    SEAM(7);
    if (IN(8)) {
        pg8::Gemm g{X1B, W1T, DM, DM, DM / 64, 1, 0}; pg8::StaticOrder S; S.init(32, FF / 256, G, bx);
        pg8::EpiB<1> E{Hb, FF, a.b_ff1};
        pg8::gemm_phase<pg8::EpiB<1>>(lds, g, S, E);
    }
    SEAM(8);
    if (IN(9)) {
        pg8::Gemm g{Hb, W2T, FF, FF, FF / 64, 1, 0}; pg8::StaticOrder S; S.init(32, 8, G, bx);
        pg8::EpiRes E{X1, V2, a.b_ff2, DN_ALPHA};
        pg8::gemm_phase<pg8::EpiRes>(lds, g, S, E);
    }
    SEAM(9);
    if (IN(10)) { THREAD_IDS(); ln_rows(V2, a.ln2_g, a.ln2_b, a.out, nullptr, gw, NGW, lane); }
#undef IN
#undef SEAM
}

extern "C" void kernel_launch(void* const* d_in, const int* in_sizes, int n_in, void* d_out, int out_size, void* d_ws, size_t ws_size, hipStream_t stream) {
    static int grid = 0;
    if (grid == 0) {
        if (n_in != 23 || in_sizes[0] != MT * DM || out_size != MT * DM || ws_size < WS_END) { fprintf(stderr, "kernel_launch: unexpected shapes (n_in %d, ws %zu)\n", n_in, ws_size); grid = -1; return; }
        int dev = 0, cus = 0, per_cu = 0;
        hipGetDevice(&dev); hipDeviceGetAttribute(&cus, hipDeviceAttributeMultiprocessorCount, dev);
        if (hipFuncSetAttribute((const void*)fwd_kernel, hipFuncAttributeMaxDynamicSharedMemorySize, LDS_BYTES) != hipSuccess) { fprintf(stderr, "kernel_launch: hipFuncSetAttribute failed\n"); grid = -1; return; }
        hipOccupancyMaxActiveBlocksPerMultiprocessor(&per_cu, (const void*)fwd_kernel, 512, LDS_BYTES);
        (void)hipGetLastError();
        if (per_cu < 1) per_cu = 1;
        grid = cus * per_cu;
        if (grid > 256) grid = 256;
    }
    if (grid < 0) return;
    Args a{};
    const float** ap = (const float**)&a;
    for (int i = 0; i < 23; ++i) ap[i] = (const float*)d_in[i];
    a.out = (float*)d_out; a.ws = (unsigned char*)d_ws;
#if MK_N_LAUNCHES == 1
    a.ph_lo = 0; a.ph_hi = NPHASE;
    void* args[] = {&a};
    hipError_t e = hipLaunchCooperativeKernel((const void*)fwd_kernel, dim3(grid), dim3(512), args, LDS_BYTES, stream);
    if (e != hipSuccess) fprintf(stderr, "cooperative launch failed: %s (grid %d)\n", hipGetErrorString(e), grid);
#else
    for (int p = 0; p < NPHASE; ++p) { a.ph_lo = p; a.ph_hi = p + 1; hipLaunchKernelGGL(fwd_kernel, dim3(grid), dim3(512), LDS_BYTES, stream, a); }
#endif
}
```

```cpp
#include <hip/hip_runtime.h>
#include <hip/hip_cooperative_groups.h>
#include <cstdio>
#include <cstdint>
namespace cg = cooperative_groups;

#ifndef MK_N_LAUNCHES
#define MK_N_LAUNCHES 1
#endif

namespace pg8 {
#define PG8_LAS __attribute__((address_space(3)))
typedef unsigned short bf16_t;
typedef short bf16x8 __attribute__((ext_vector_type(8)));
typedef float f32x4 __attribute__((ext_vector_type(4)));
typedef float f32x2 __attribute__((ext_vector_type(2)));
typedef unsigned u32x4 __attribute__((ext_vector_type(4)));
typedef unsigned u32x2 __attribute__((ext_vector_type(2)));
constexpr int BM = 256, BK = 64, HALF = 128, HTB = HALF * BK * 2, STAGE_BYTES = 8 * HTB, NXCD = 8, WGM = 8;

__host__ __device__ __forceinline__ int lds_byte(int r, int c) { const int st = (r >> 4) * 2 + (c >> 5), rr = r & 15, cc = c & 31, ob = rr * 64 + cc * 2; return st * 1024 + (ob ^ (((ob >> 9) & 1) << 5)); }
__host__ __device__ __forceinline__ void stage_rc(int b, int& R, int& C) { const int st = b / 1024, sb = b % 1024, swz = sb ^ (((sb >> 9) & 1) << 5); R = (st >> 1) * 16 + swz / 64; C = (st & 1) * 32 + (swz % 64) / 2; }
__host__ __device__ __forceinline__ int perm32(int rho) { const int n = rho >> 4, i = rho & 15; return 8 * (i >> 2) + 4 * n + (i & 3); }

struct Unit { int pm, pn; };
struct Gemm { const bf16_t* A; const bf16_t* Bt; int lda, ldb, nt, adiv, astride; };

struct StaticOrder {
    int nM, nN, nwg, G, c;
    __device__ void init(int nM_, int nN_, int G_, int c_) { nM = nM_; nN = nN_; nwg = nM * nN; G = G_; c = c_; }
    __device__ bool next(int i, Unit& u) const {
        const long L = (long)i * G + c; if (L >= nwg) return false;
        int wgid = (int)L; { const int q = nwg / NXCD, r = nwg % NXCD, xcd = wgid % NXCD, off = wgid / NXCD; wgid = (xcd < r ? xcd * (q + 1) : r * (q + 1) + (xcd - r) * q) + off; }
        const int nig = WGM * nN, gid = wgid / nig, fm = gid * WGM, gsz = (nM - fm) < WGM ? (nM - fm) : WGM;
        u.pm = fm + ((wgid % nig) % gsz); u.pn = (wgid % nig) / gsz; return true;
    }
};

__device__ __forceinline__ unsigned cvt_pk_bf16(float lo, float hi) { unsigned r; asm volatile("v_cvt_pk_bf16_f32 %0, %1, %2" : "=v"(r) : "v"(lo), "v"(hi)); return r; }
__device__ __forceinline__ float bf_lo(unsigned w) { return __builtin_bit_cast(float, w << 16); }
__device__ __forceinline__ float bf_hi(unsigned w) { return __builtin_bit_cast(float, w & 0xffff0000u); }
__device__ __forceinline__ float fsigmoid(float v) { return __builtin_amdgcn_rcpf(1.0f + __builtin_amdgcn_exp2f(-1.44269504f * v)); }
__device__ __forceinline__ float gelu_tanh(float v) { const float y = v * (1.0f + 0.044715f * v * v); return v * __builtin_amdgcn_rcpf(1.0f + __builtin_amdgcn_exp2f(-2.30220819f * y)); }
template <int CTRL> __device__ __forceinline__ float dpp(float old, float src) {
    return __builtin_bit_cast(float, __builtin_amdgcn_update_dpp(__builtin_bit_cast(int, old), __builtin_bit_cast(int, src), CTRL, 0xf, 0xf, false));
}
#define EPI_BAR() do { asm volatile("s_waitcnt lgkmcnt(0)" ::: "memory"); __builtin_amdgcn_s_barrier(); asm volatile("" ::: "memory"); } while (0)

typedef f32x4 Acc[2][2][4][2];
constexpr int MT = 8192, DM = 2048;

struct EpiZ {
    static constexpr bool PERM = true, MID = false;
    bf16_t* Z0;
    __device__ __forceinline__ void operator()(Acc& acc, const Unit& u, int wr, int wc, int fr, int fq, PG8_LAS unsigned char*) const {
        const int region = u.pn >> 3;
        bf16_t* base = Z0 + (size_t)region * ((size_t)MT * DM) + (size_t)(u.pm * BM + wr * 64 + fr) * DM + (u.pn & 7) * BM + wc * 32 + 8 * fq;
#pragma unroll
        for (int ai = 0; ai < 2; ++ai)
#pragma unroll
            for (int m = 0; m < 4; ++m) { bf16_t* rowp = base + (size_t)(ai * HALF + m * 16) * DM;
#pragma unroll
                for (int bj = 0; bj < 2; ++bj) { f32x4 v0 = acc[ai][bj][m][0], v1 = acc[ai][bj][m][1];
                    if (region == 2) {
#pragma unroll
                        for (int e = 0; e < 4; ++e) { v0[e] = gelu_tanh(v0[e]); v1[e] = gelu_tanh(v1[e]); }
                    } else if (region >= 3) {
#pragma unroll
                        for (int e = 0; e < 4; ++e) { v0[e] = fsigmoid(v0[e]); v1[e] = fsigmoid(v1[e]); }
                    }
                    u32x4 w; w.x = cvt_pk_bf16(v0[0], v0[1]); w.y = cvt_pk_bf16(v0[2], v0[3]); w.z = cvt_pk_bf16(v1[0], v1[1]); w.w = cvt_pk_bf16(v1[2], v1[3]);
                    *(u32x4*)(rowp + bj * HALF) = w; } }
    }
};
template <int MODE> struct EpiB {
    static constexpr bool PERM = true, MID = false;
    bf16_t* O; int ldc; const float* vec;
    __device__ __forceinline__ void operator()(Acc& acc, const Unit& u, int wr, int wc, int fr, int fq, PG8_LAS unsigned char*) const {
        const int col0 = u.pn * BM + wc * 32 + 8 * fq;
        f32x4 bv[2][2];
#pragma unroll
        for (int bj = 0; bj < 2; ++bj)
#pragma unroll
            for (int n = 0; n < 2; ++n) bv[bj][n] = *(const f32x4*)(vec + col0 + bj * HALF + 4 * n);
        bf16_t* base = O + (size_t)(u.pm * BM + wr * 64 + fr) * ldc + col0;
#pragma unroll
        for (int ai = 0; ai < 2; ++ai)
#pragma unroll
            for (int m = 0; m < 4; ++m) { bf16_t* rowp = base + (size_t)(ai * HALF + m * 16) * ldc;
#pragma unroll
                for (int bj = 0; bj < 2; ++bj) { f32x4 v0, v1;
                    if (MODE == 0) { v0 = acc[ai][bj][m][0] * bv[bj][0]; v1 = acc[ai][bj][m][1] * bv[bj][1]; }
                    else { v0 = acc[ai][bj][m][0] + bv[bj][0]; v1 = acc[ai][bj][m][1] + bv[bj][1];
#pragma unroll
                        for (int e = 0; e < 4; ++e) { const float a = fmaxf(v0[e], 0.f), b = fmaxf(v1[e], 0.f); v0[e] = a * a; v1[e] = b * b; } }
                    u32x4 w; w.x = cvt_pk_bf16(v0[0], v0[1]); w.y = cvt_pk_bf16(v0[2], v0[3]); w.z = cvt_pk_bf16(v1[0], v1[1]); w.w = cvt_pk_bf16(v1[2], v1[3]);
                    *(u32x4*)(rowp + bj * HALF) = w; } }
    }
};
struct EpiMerge {
    static constexpr bool PERM = true, MID = true;
    const bf16_t* GA; const bf16_t* GB; bf16_t* O;
    __device__ __forceinline__ void mid(Acc& acc, const Unit& u, int wr, int wc, int fr, int fq) const {
        const size_t off0 = (size_t)(u.pm * BM + wr * 64 + fr) * DM + u.pn * BM + wc * 32 + 8 * fq;
#pragma unroll
        for (int ai = 0; ai < 2; ++ai)
#pragma unroll
            for (int m = 0; m < 4; ++m) {
#pragma unroll
                for (int bj = 0; bj < 2; ++bj) { const size_t off = off0 + (size_t)(ai * HALF + m * 16) * DM + bj * HALF;
                    const u32x4 a = *(const u32x4*)(GA + off), b = *(const u32x4*)(GB + off);
                    f32x4 r0, r1;
                    r0[0] = bf_lo(a.x) * __builtin_amdgcn_rcpf(bf_lo(b.x)); r0[1] = bf_hi(a.x) * __builtin_amdgcn_rcpf(bf_hi(b.x));
                    r0[2] = bf_lo(a.y) * __builtin_amdgcn_rcpf(bf_lo(b.y)); r0[3] = bf_hi(a.y) * __builtin_amdgcn_rcpf(bf_hi(b.y));
                    r1[0] = bf_lo(a.z) * __builtin_amdgcn_rcpf(bf_lo(b.z)); r1[1] = bf_hi(a.z) * __builtin_amdgcn_rcpf(bf_hi(b.z));
                    r1[2] = bf_lo(a.w) * __builtin_amdgcn_rcpf(bf_lo(b.w)); r1[3] = bf_hi(a.w) * __builtin_amdgcn_rcpf(bf_hi(b.w));
                    acc[ai][bj][m][0] *= r0; acc[ai][bj][m][1] *= r1; }
                asm volatile("" ::: "memory"); }
    }
    __device__ __forceinline__ void operator()(Acc& acc, const Unit& u, int wr, int wc, int fr, int fq, PG8_LAS unsigned char*) const {
        const size_t off0 = (size_t)(u.pm * BM + wr * 64 + fr) * DM + u.pn * BM + wc * 32 + 8 * fq;
#pragma unroll
        for (int ai = 0; ai < 2; ++ai)
#pragma unroll
            for (int m = 0; m < 4; ++m) {
#pragma unroll
                for (int bj = 0; bj < 2; ++bj) { const size_t off = off0 + (size_t)(ai * HALF + m * 16) * DM + bj * HALF;
                    const u32x4 b = *(const u32x4*)(GB + off);
                    const f32x4 v0 = acc[ai][bj][m][0], v1 = acc[ai][bj][m][1];
                    u32x4 w; w.x = cvt_pk_bf16(v0[0] * bf_lo(b.x), v0[1] * bf_hi(b.x)); w.y = cvt_pk_bf16(v0[2] * bf_lo(b.y), v0[3] * bf_hi(b.y));
                    w.z = cvt_pk_bf16(v1[0] * bf_lo(b.z), v1[1] * bf_hi(b.z)); w.w = cvt_pk_bf16(v1[2] * bf_lo(b.w), v1[3] * bf_hi(b.w));
                    *(u32x4*)(O + off) = w; }
                asm volatile("" ::: "memory"); }
    }
};
struct EpiRes {
    static constexpr bool PERM = false, MID = false;
    const float* base; float* out; const float* bias; float alpha;
    __device__ __forceinline__ void operator()(Acc& acc, const Unit& u, int wr, int wc, int fr, int fq, PG8_LAS unsigned char*) const {
        const int col0 = u.pn * BM + wc * 32 + 4 * fq;
        f32x4 bv[2][2];
#pragma unroll
        for (int bj = 0; bj < 2; ++bj)
#pragma unroll
            for (int n = 0; n < 2; ++n) bv[bj][n] = *(const f32x4*)(bias + col0 + bj * HALF + n * 16);
        const size_t off0 = (size_t)(u.pm * BM + wr * 64 + fr) * DM + col0;
#pragma unroll
        for (int ai = 0; ai < 2; ++ai)
#pragma unroll
            for (int m = 0; m < 4; ++m) { const size_t off = off0 + (size_t)(ai * HALF + m * 16) * DM;
#pragma unroll
                for (int bj = 0; bj < 2; ++bj)
#pragma unroll
                    for (int n = 0; n < 2; ++n) { const f32x4 bs = *(const f32x4*)(base + off + bj * HALF + n * 16);
                        *(f32x4*)(out + off + bj * HALF + n * 16) = bs * alpha + acc[ai][bj][m][n] + bv[bj][n]; }
                asm volatile("" ::: "memory"); }
    }
};
#define GATE_SCAN(SHIFT, a, b) do { float ap_, bp_; \
    ap_ = dpp<SHIFT + 1>(1.0f, a); bp_ = dpp<SHIFT + 1>(0.0f, b); b = a * bp_ + b; a = a * ap_; \
    ap_ = dpp<SHIFT + 2>(1.0f, a); bp_ = dpp<SHIFT + 2>(0.0f, b); b = a * bp_ + b; a = a * ap_; \
    ap_ = dpp<SHIFT + 4>(1.0f, a); bp_ = dpp<SHIFT + 4>(0.0f, b); b = a * bp_ + b; a = a * ap_; \
    ap_ = dpp<SHIFT + 8>(1.0f, a); bp_ = dpp<SHIFT + 8>(0.0f, b); b = a * bp_ + b; a = a * ap_; } while (0)
template <int PASS> struct EpiGate {
    static constexpr bool PERM = false, MID = false;
    const bf16_t* XC; const bf16_t* GG; bf16_t* YY; const float* BA; const float* BX; const float* KC; f32x2* AGG;
    __device__ __forceinline__ void operator()(Acc& acc, const Unit& u, int wr, int wc, int fr, int fq, PG8_LAS unsigned char* ldsx) const {
        const int tid = (wr * 4 + wc) * 64 + fq * 16 + fr;
        const int chb = u.pn * 64, cl = wc * 16 + fq * 4, ch0 = chb + cl;
        PG8_LAS float* GS = (PG8_LAS float*)ldsx;
        if (PASS == 2) {
            const int s = tid >> 7, d = (tid >> 6) & 1, c = tid & 63;
            const int sg = u.pm * 4 + s, b0 = sg & ~63;
            const f32x2* ag = AGG + (size_t)d * DM + chb + c;
            float cy = 0.f;
            if (d == 0) { for (int p = b0; p < sg; ++p) { const f32x2 ah = ag[(size_t)p * (2 * DM)]; cy = ah.x * cy + ah.y; } }
            else { for (int p = b0 + 63; p > sg; --p) { const f32x2 ah = ag[(size_t)p * (2 * DM)]; cy = ah.x * cy + ah.y; } }
            GS[tid] = cy;
            EPI_BAR();
        }
        const unsigned rbase = (unsigned)((u.pm * BM + wr * 64 + fr) * DM + ch0);
#define GATE_ELEM(ai, d) do { \
            int cho_ = (d) * DM + ch0; asm volatile("" : "+v"(cho_)); \
            const f32x4 ba_ = *(const f32x4*)(BA + cho_), bx_ = *(const f32x4*)(BX + cho_), kc_ = *(const f32x4*)(KC + cho_); \
            _Pragma("unroll") for (int m = 0; m < 4; ++m) { \
                unsigned xoff = rbase + (unsigned)(((ai) * HALF + m * 16) * DM); asm volatile("" : "+v"(xoff)); \
                const u32x2 xw = *(const u32x2*)(XC + xoff); \
                f32x4 xv; xv[0] = bf_lo(xw.x); xv[1] = bf_hi(xw.x); xv[2] = bf_lo(xw.y); xv[3] = bf_hi(xw.y); \
                _Pragma("unroll") for (int e = 0; e < 4; ++e) { \
                    const float r = fsigmoid(acc[ai][d][m][0][e] + ba_[e]); \
                    const float ig = fsigmoid(acc[ai][d][m][1][e] + bx_[e]); \
                    const float a = __builtin_amdgcn_exp2f(kc_[e] * r); \
                    const float sq = __builtin_amdgcn_sqrtf(fmaxf(1.0f - a * a, 0.f)); \
                    acc[ai][d][m][0][e] = a; acc[ai][d][m][1][e] = sq * (ig * xv[e]); } \
                asm volatile("" ::: "memory"); __builtin_amdgcn_sched_barrier(0); } } while (0)
#pragma unroll
        for (int ai = 0; ai < 2; ++ai) {
            const int s = 2 * ai + wr;
            f32x4 cf = (f32x4){0.f, 0.f, 0.f, 0.f}, cb = cf, Af = (f32x4){1.f, 1.f, 1.f, 1.f}, Ab = Af;
            GATE_ELEM(ai, 0);
            if (PASS == 2) cf = *(const PG8_LAS f32x4*)(GS + (s * 2 + 0) * 64 + cl);
#pragma unroll
            for (int m = 0; m < 4; ++m) {
#pragma unroll
                for (int e = 0; e < 4; ++e) {
                    float a = acc[ai][0][m][0][e], b = acc[ai][0][m][1][e];
                    GATE_SCAN(0x110, a, b);
                    const float h = a * cf[e] + b;
                    acc[ai][0][m][1][e] = h; cf[e] = dpp<0x15F>(0.f, h);
                    if (PASS == 1) Af[e] *= dpp<0x15F>(0.f, a);
                }
                __builtin_amdgcn_sched_barrier(0);
            }
            GATE_ELEM(ai, 1);
            if (PASS == 2) cb = *(const PG8_LAS f32x4*)(GS + (s * 2 + 1) * 64 + cl);
#pragma unroll
            for (int m = 3; m >= 0; --m) {
                f32x4 hb;
#pragma unroll
                for (int e = 0; e < 4; ++e) {
                    float a = acc[ai][1][m][0][e], b = acc[ai][1][m][1][e];
                    GATE_SCAN(0x100, a, b);
                    const float h = a * cb[e] + b;
                    hb[e] = h; cb[e] = dpp<0x150>(0.f, h);
                    if (PASS == 1) Ab[e] *= dpp<0x150>(0.f, a);
                }
                if (PASS == 2) {
                    unsigned goff = rbase + (unsigned)((ai * HALF + m * 16) * DM); asm volatile("" : "+v"(goff));
                    const unsigned yoff = 2u * goff - (unsigned)ch0 + (unsigned)DM;
                    const u32x2 gw = *(const u32x2*)(GG + goff);
                    f32x4 gv; gv[0] = bf_lo(gw.x); gv[1] = bf_hi(gw.x); gv[2] = bf_lo(gw.y); gv[3] = bf_hi(gw.y);
                    const f32x4 y = (acc[ai][0][m][1] + hb) * gv;
                    u32x2 w; w.x = cvt_pk_bf16(y[0], y[1]); w.y = cvt_pk_bf16(y[2], y[3]);
                    *(u32x2*)(YY + yoff) = w;
                }
                asm volatile("" ::: "memory"); __builtin_amdgcn_sched_barrier(0);
            }
            if (PASS == 1) {
                f32x2* ag = AGG + (size_t)(u.pm * 4 + s) * (2 * DM) + ch0;
                if (fr == 15) { *(f32x4*)(ag) = (f32x4){Af[0], cf[0], Af[1], cf[1]}; *(f32x4*)(ag + 2) = (f32x4){Af[2], cf[2], Af[3], cf[3]}; }
                if (fr == 0) { *(f32x4*)(ag + DM) = (f32x4){Ab[0], cb[0], Ab[1], cb[1]}; *(f32x4*)(ag + DM + 2) = (f32x4){Ab[2], cb[2], Ab[3], cb[3]}; }
            }
        }
    }
};

template <class Epi>
__device__ __forceinline__ void gemm_phase(PG8_LAS unsigned char* lds, const Gemm g, const StaticOrder& S, const Epi& E) {
    const int tid = threadIdx.x, wid = __builtin_amdgcn_readfirstlane(tid >> 6), lane = tid & 63, wr = wid >> 2, wc = wid & 3, fr = lane & 15, fq = lane >> 4;
    const int nt = g.nt;
    unsigned voffA[2], voffB[2];
#pragma unroll
    for (int i = 0; i < 2; ++i) { int R, C; stage_rc(tid * 16 + i * 8192, R, C); const int Rb = Epi::PERM ? ((R & ~31) + perm32(R & 31)) : R;
        voffA[i] = (unsigned)(R * g.lda + C) * 2u; voffB[i] = (unsigned)(Rb * g.ldb + C) * 2u; }
    const size_t kstep = (size_t)(BK * 2);
    const size_t hstepA = (size_t)HALF * g.lda * 2, hstepB = (size_t)HALF * g.ldb * 2;
    const unsigned ldsw = (unsigned)wid * 1024u;
    const int aoff = lds_byte(wr * 64 + fr, fq * 8), boff = lds_byte(wc * 32 + fr, fq * 8);
    PG8_LAS unsigned char* ldsx = lds + STAGE_BYTES;
#define PG8_UA(u) ((const char*)g.A + ((size_t)(u).pm * BM * g.lda + (size_t)((u).pn / g.adiv) * g.astride) * 2)
#define PG8_UB(u) ((const char*)g.Bt + (size_t)(u).pn * BM * g.ldb * 2)
#define PG8_SA(b, h) (((b) * 2 + (h)) * HTB)
#define PG8_SB(b, h) ((4 + (b) * 2 + (h)) * HTB)
#define PG8_STAGE(bufoff, gbase, voff) do { _Pragma("unroll") for (int _i = 0; _i < 2; ++_i) \
        __builtin_amdgcn_global_load_lds((const unsigned*)((const char*)(gbase) + (voff)[_i]), (PG8_LAS unsigned*)(lds + (bufoff) + ldsw + _i * 8192), 16, 0, 0); } while (0)
#define PG8_LDA(dst, b, h) do { _Pragma("unroll") for (int m = 0; m < 4; ++m) _Pragma("unroll") for (int k = 0; k < 2; ++k) dst[m][k] = *(const PG8_LAS bf16x8*)(lds + PG8_SA(b, h) + aoff + m * 2048 + k * 1024); } while (0)
#define PG8_LDB(dst, b, h) do { _Pragma("unroll") for (int n = 0; n < 2; ++n) _Pragma("unroll") for (int k = 0; k < 2; ++k) dst[n][k] = *(const PG8_LAS bf16x8*)(lds + PG8_SB(b, h) + boff + n * 2048 + k * 1024); } while (0)
#define PG8_MMA(ai, bj, At, Bt) do { __builtin_amdgcn_s_setprio(1); _Pragma("unroll") for (int m = 0; m < 4; ++m) _Pragma("unroll") for (int n = 0; n < 2; ++n) _Pragma("unroll") for (int k = 0; k < 2; ++k) \
        acc[ai][bj][m][n] = __builtin_amdgcn_mfma_f32_16x16x32_bf16(Bt[n][k], At[m][k], acc[ai][bj][m][n], 0, 0, 0); __builtin_amdgcn_s_setprio(0); } while (0)
#define PG8_WAIT_V(n) asm volatile("s_waitcnt vmcnt(" #n ")" ::: "memory")
#define PG8_WAIT_L(n) asm volatile("s_waitcnt lgkmcnt(" #n ")" ::: "memory")
#define PG8_BAR __builtin_amdgcn_s_barrier()
#define PG8_SCHED __builtin_amdgcn_sched_barrier(0)
    Unit cur, nxt; int ui = 0;
    if (!S.next(0, cur)) return;
    Acc acc;
#pragma unroll
    for (int a = 0; a < 2; ++a)
#pragma unroll
        for (int b = 0; b < 2; ++b)
#pragma unroll
            for (int m = 0; m < 4; ++m)
#pragma unroll
                for (int n = 0; n < 2; ++n) acc[a][b][m][n] = (f32x4){0.f, 0.f, 0.f, 0.f};
    bf16x8 At[4][2], B0[2][2], B1[2][2];
    const char* cA = PG8_UA(cur); const char* cB = PG8_UB(cur);
    PG8_STAGE(PG8_SB(0, 0), cB, voffB); PG8_STAGE(PG8_SB(0, 1), cB + hstepB, voffB); PG8_STAGE(PG8_SA(0, 0), cA, voffA); PG8_STAGE(PG8_SA(0, 1), cA + hstepA, voffA);
    if (wr == 1) PG8_BAR;
    PG8_WAIT_V(2); PG8_BAR;
    PG8_STAGE(PG8_SB(1, 0), cB + kstep, voffB); PG8_STAGE(PG8_SA(1, 0), cA + kstep, voffA); PG8_STAGE(PG8_SB(1, 1), cB + hstepB + kstep, voffB);
    PG8_WAIT_V(6); PG8_BAR;
    for (;;) {
        const bool has_next = S.next(ui + 1, nxt);
        const char* nA = has_next ? PG8_UA(nxt) : cA; const char* nB = has_next ? PG8_UB(nxt) : cB;
        for (int t = 0; t < nt; t += 2) {
            if constexpr (Epi::MID) { if (t == (nt >> 1)) { int fr_ = fr, fq_ = fq; asm volatile("" : "+v"(fr_), "+v"(fq_)); E.mid(acc, cur, wr, wc, fr_, fq_); } }
            const bool last = (t == nt - 2);
            const char* a1 = cA + (size_t)(t + 1) * kstep;
            const char* a2 = last ? nA : cA + (size_t)(t + 2) * kstep; const char* b2 = last ? nB : cB + (size_t)(t + 2) * kstep;
            const char* a3 = a2 + kstep; const char* b3 = b2 + kstep;
            PG8_LDB(B0, 0, 0); PG8_LDB(B1, 0, 1); PG8_SCHED; PG8_LDA(At, 0, 0); PG8_STAGE(PG8_SA(1, 1), a1 + hstepA, voffA);
            PG8_WAIT_V(8); PG8_WAIT_L(0); PG8_BAR; PG8_MMA(0, 0, At, B0); PG8_MMA(0, 1, At, B1); PG8_BAR; PG8_SCHED;
            PG8_LDA(At, 0, 1); PG8_STAGE(PG8_SB(0, 0), b2, voffB); PG8_STAGE(PG8_SB(0, 1), b2 + hstepB, voffB); PG8_STAGE(PG8_SA(0, 0), a2, voffA);
            PG8_WAIT_V(8); PG8_WAIT_L(0); PG8_BAR; PG8_MMA(1, 0, At, B0); PG8_MMA(1, 1, At, B1); PG8_BAR; PG8_SCHED;
            PG8_LDB(B0, 1, 0); PG8_LDB(B1, 1, 1); PG8_SCHED; PG8_LDA(At, 1, 0); PG8_STAGE(PG8_SA(0, 1), a2 + hstepA, voffA);
            PG8_WAIT_V(8); PG8_WAIT_L(0); PG8_BAR; PG8_MMA(0, 0, At, B0); PG8_MMA(0, 1, At, B1); PG8_BAR; PG8_SCHED;
            PG8_LDA(At, 1, 1); PG8_STAGE(PG8_SB(1, 0), b3, voffB); PG8_STAGE(PG8_SB(1, 1), b3 + hstepB, voffB); PG8_STAGE(PG8_SA(1, 0), a3, voffA);
            PG8_WAIT_V(8); PG8_WAIT_L(0); PG8_BAR; PG8_MMA(1, 0, At, B0); PG8_MMA(1, 1, At, B1); PG8_BAR; PG8_SCHED;
        }
        if (wr == 0) PG8_BAR;
        asm volatile("" ::: "memory"); __builtin_amdgcn_sched_barrier(0);
        { int fr_ = fr, fq_ = fq; asm volatile("" : "+v"(fr_), "+v"(fq_)); E(acc, cur, wr, wc, fr_, fq_, ldsx); }
        if (!has_next) break;
#pragma unroll
        for (int a = 0; a < 2; ++a)
#pragma unroll
            for (int b = 0; b < 2; ++b)
#pragma unroll
                for (int m = 0; m < 4; ++m)
#pragma unroll
                    for (int n = 0; n < 2; ++n) acc[a][b][m][n] = (f32x4){0.f, 0.f, 0.f, 0.f};
        cur = nxt; cA = nA; cB = nB; ++ui;
        if (wr == 1) PG8_BAR;
    }
    PG8_WAIT_V(0);
    PG8_BAR;
#undef PG8_UA
#undef PG8_UB
#undef PG8_SA
#undef PG8_SB
#undef PG8_STAGE
#undef PG8_LDA
#undef PG8_LDB
#undef PG8_MMA
#undef PG8_WAIT_V
#undef PG8_WAIT_L
#undef PG8_BAR
#undef PG8_SCHED
}
}

using pg8::bf16_t; using pg8::f32x4; using pg8::f32x2; using pg8::u32x4; using pg8::u32x2;
#define LAS __attribute__((address_space(3)))
constexpr int MT = 8192, DM = 2048, SEQ = 4096, NIN = 10240, FF = 8192;
constexpr float DN_ALPHA = 1.189207115002721f, LN_EPS = 1e-5f;
constexpr size_t MiB = 1u << 20;
constexpr size_t WS_BAR = 65536, WS_BAR_BYTES = 16384;
constexpr size_t WS_KC = 0, WS_AGG = 296 * MiB;
constexpr size_t WS_WIN = 2 * MiB, WS_XB = 42 * MiB, WS_POOLT = 74 * MiB, WS_WG = 76 * MiB, WS_WUP = 80 * MiB, WS_WOUT = 96 * MiB;
constexpr size_t WS_Z = 104 * MiB;
constexpr size_t WS_UP = WS_Z, WS_UL = WS_Z + 32 * MiB, WS_GG = WS_Z + 64 * MiB, WS_GA = WS_Z + 96 * MiB, WS_GB = WS_Z + 128 * MiB;
constexpr size_t WS_D = 264 * MiB, WS_XC = 34 * MiB, WS_W1 = 2 * MiB;
constexpr size_t WS_YY = 104 * MiB, WS_MB = 264 * MiB, WS_V1 = 168 * MiB;
constexpr size_t WS_X1 = 232 * MiB, WS_X1B = 34 * MiB, WS_W2 = 66 * MiB, WS_H = 104 * MiB, WS_V2 = 2 * MiB;
constexpr size_t WS_END = 320 * MiB;
constexpr int LDS_BYTES = 147456, LDS_MISC = 131072 + 12288;
constexpr int NPHASE = 11;


#define XB_TMO      128
#define XB_XCNT(j)  (256  + 64 * (j))
#define XB_XSUB(j)  (1280 + 64 * (j))
#define XB_XGEN(j)  (2304 + 64 * (j))
#define XB_TOP      3328
#define XB_TOPGEN   3392
#define XCD_BAR_WORDS 3456
#define XB_SPIN_CAP (1u << 18)
__device__ __forceinline__ unsigned xb_ld(unsigned* p)              { return __hip_atomic_load(p, __ATOMIC_RELAXED, __HIP_MEMORY_SCOPE_AGENT); }
__device__ __forceinline__ unsigned xb_add(unsigned* p, unsigned v) { return __hip_atomic_fetch_add(p, v, __ATOMIC_RELAXED, __HIP_MEMORY_SCOPE_AGENT); }
__device__ __forceinline__ unsigned xb_xcc_id() { return (unsigned)__builtin_amdgcn_s_getreg((3 << 11) | 20) & 0xFu; }
#define XB_SPIN(cond, bar) do { unsigned _sp = 0; while (cond) { __builtin_amdgcn_s_sleep(1); \
    if ((++_sp & 255u) == 0u) { if (xb_ld(&(bar)[XB_TMO])) break; if (_sp > XB_SPIN_CAP) { atomicAdd(&(bar)[XB_TMO], 1u); break; } } } } while (0)
struct XcdBarrier { unsigned* bar; unsigned x; volatile LAS unsigned* st; };
__device__ __forceinline__ XcdBarrier xcd_barrier_post(unsigned* bar, volatile LAS unsigned* st) {
    XcdBarrier b; b.bar = bar; b.x = xb_xcc_id(); b.st = st;
    if (threadIdx.x == 0) (void)xb_add(&bar[XB_XCNT(b.x)], 1u);
    return b;
}
__device__ __forceinline__ void xcd_barrier_complete(unsigned* bar, unsigned x, unsigned& nloc, unsigned& nx) {
    const unsigned G = gridDim.x * gridDim.y * gridDim.z;
    unsigned sum, cnt, mine, sp = 0u;
    for (;;) {
        sum = 0u; cnt = 0u; mine = 0u;
#pragma unroll
        for (unsigned j = 0; j < 16; ++j) { const unsigned c = xb_ld(&bar[XB_XCNT(j)]); sum += c; cnt += (c > 0u) ? 1u : 0u; mine = (j == x) ? c : mine; }
        if (sum == G) break;
        __builtin_amdgcn_s_sleep(1);
        if ((++sp & 255u) == 0u) { if (xb_ld(&bar[XB_TMO])) break; if (sp > XB_SPIN_CAP) { atomicAdd(&bar[XB_TMO], 1u); break; } }
    }
    nloc = mine > 0u ? mine : 1u; nx = cnt > 0u ? cnt : 1u;
}
__device__ __forceinline__ void xcd_barrier(const XcdBarrier& b) {
    asm volatile("s_waitcnt vmcnt(0)" ::: "memory");
    __syncthreads();
    if (threadIdx.x == 0) {
        unsigned* bar = b.bar;
        __builtin_amdgcn_s_waitcnt(0);
        unsigned nloc = b.st[0], nx = b.st[1];
        if (nloc == 0u) { xcd_barrier_complete(bar, b.x, nloc, nx); b.st[0] = nloc; b.st[1] = nx; }
        const unsigned old = xb_add(&bar[XB_XSUB(b.x)], 1u);
        const unsigned gen = old / nloc;
        if (old + 1u == (gen + 1u) * nloc) {
            __builtin_amdgcn_fence(__ATOMIC_RELEASE, "agent");
            asm volatile("s_waitcnt vmcnt(0)" ::: "memory");
            const unsigned og = xb_add(&bar[XB_TOP], 1u);
            const unsigned tg = og / nx;
            if (og + 1u == (tg + 1u) * nx) xb_add(&bar[XB_TOPGEN], 1u);
            else XB_SPIN(xb_ld(&bar[XB_TOPGEN]) == tg, bar);
            __builtin_amdgcn_fence(__ATOMIC_ACQUIRE, "agent");
            xb_add(&bar[XB_XGEN(b.x)], 1u);
            asm volatile("s_waitcnt vmcnt(0)" ::: "memory");
        } else {
            XB_SPIN(xb_ld(&bar[XB_XGEN(b.x)]) == gen, bar);
            __builtin_amdgcn_fence(__ATOMIC_ACQUIRE, "agent");
            asm volatile("s_waitcnt vmcnt(0)" ::: "memory");
        }
    }
    __syncthreads();
}

__device__ __forceinline__ float wave_sum(float v) {
#pragma unroll
    for (int o = 1; o < 64; o <<= 1) v += __shfl_xor(v, o);
    return v;
}
__device__ __forceinline__ void transpose_item(const float* S, int lds_, bf16_t* Dst, int ldd, int k0, int n0, int mode, int dgoff, LAS float* scr, int lane) {
    {
        const int kr = lane >> 4, nc = (lane & 15) * 4;
        const float* sp = S + (size_t)(k0 + kr) * lds_ + n0 + nc;
#pragma unroll
        for (int i = 0; i < 16; ++i) { const f32x4 v = *(const f32x4*)(sp + (size_t)(4 * i) * lds_); LAS float* d = scr + (4 * i + kr) * 65 + nc; d[0] = v[0]; d[1] = v[1]; d[2] = v[2]; d[3] = v[3]; }
    }
    asm volatile("s_waitcnt lgkmcnt(0)" ::: "memory");
#pragma unroll
    for (int j = 0; j < 8; ++j) {
        const int q = j * 64 + lane, n = q >> 3, c = q & 7;
        const LAS float* s = scr + (8 * c) * 65 + n;
        u32x4 o; o.x = pg8::cvt_pk_bf16(s[0], s[65]); o.y = pg8::cvt_pk_bf16(s[130], s[195]); o.z = pg8::cvt_pk_bf16(s[260], s[325]); o.w = pg8::cvt_pk_bf16(s[390], s[455]);
        const int nn = n0 + n;
        const int row = mode == 0 ? nn : ((nn >> 6) * 256 + dgoff + ((nn & 63) >> 4) * 32 + (nn & 15));
        *(u32x4*)(Dst + (size_t)row * ldd + k0 + 8 * c) = o;
    }
    asm volatile("s_waitcnt lgkmcnt(0)" ::: "memory");
}
__device__ __forceinline__ void transpose_matrix(const float* S, int K, int N, bf16_t* Dst, int ldd, int it, LAS float* scr, int lane) {
    const int nblk = N >> 6, kb = it / nblk, nb = it % nblk;
    transpose_item(S, N, Dst, ldd, kb * 64, nb * 64, 0, 0, scr, lane);
}

struct Args {
    const float *x, *w_in, *pool_w, *pool_scale, *conv_w, *conv_b, *lru_wa, *lru_ba, *lru_wx, *lru_bx, *lru_lambda, *w_pool_up, *w_lru_up, *w_out, *b_out,
        *ln1_g, *ln1_b, *w_ff1, *b_ff1, *w_ff2, *b_ff2, *ln2_g, *ln2_b;
    float* out; unsigned char* ws; int ph_lo, ph_hi;
};

__device__ __forceinline__ void ln_rows(const float* V, const float* g, const float* b, float* outf, bf16_t* outb, int gw, int NGW, int lane) {
    for (int row = gw; row < MT; row += NGW) {
        const f32x4* vr = (const f32x4*)(V + (size_t)row * DM) + lane;
        f32x4 v[8]; float s = 0.f;
#pragma unroll
        for (int j = 0; j < 8; ++j) { v[j] = vr[64 * j]; s += (v[j][0] + v[j][1]) + (v[j][2] + v[j][3]); }
        const float mean = wave_sum(s) * (1.f / DM); float s2 = 0.f;
#pragma unroll
        for (int j = 0; j < 8; ++j) { v[j] = v[j] - mean; s2 += (v[j][0] * v[j][0] + v[j][1] * v[j][1]) + (v[j][2] * v[j][2] + v[j][3] * v[j][3]); }
        const float rstd = 1.0f / sqrtf(wave_sum(s2) * (1.f / DM) + LN_EPS);
#pragma unroll
        for (int j = 0; j < 8; ++j) {
            const f32x4 gg = *((const f32x4*)g + lane + 64 * j), bb = *((const f32x4*)b + lane + 64 * j);
            const f32x4 y = v[j] * rstd * gg + bb;
            *((f32x4*)(outf + (size_t)row * DM) + lane + 64 * j) = y;
            if (outb) { u32x2 w; w.x = pg8::cvt_pk_bf16(y[0], y[1]); w.y = pg8::cvt_pk_bf16(y[2], y[3]); *((u32x2*)(outb + (size_t)row * DM) + lane + 64 * j) = w; }
        }
    }
}

__global__ void __launch_bounds__(512, 2) fwd_kernel(Args a) {
    extern __shared__ __attribute__((aligned(16))) unsigned char lds_raw[];
    LAS unsigned char* lds = (LAS unsigned char*)lds_raw;
    const int G = gridDim.x, bx = blockIdx.x;
#define THREAD_IDS() int tid = threadIdx.x; asm volatile("" : "+v"(tid)); const int lane = tid & 63, wave = __builtin_amdgcn_readfirstlane(tid >> 6); \
    const int gw = bx * 8 + wave, NGW = G * 8, gt = bx * 512 + tid, NT = G * 512; LAS float* scr = (LAS float*)(lds + wave * 16640); (void)lane; (void)gw; (void)NGW; (void)gt; (void)NT; (void)scr
    unsigned char* ws = a.ws;
    bf16_t* WinT = (bf16_t*)(ws + WS_WIN); bf16_t* XB = (bf16_t*)(ws + WS_XB); bf16_t* PoolT = (bf16_t*)(ws + WS_POOLT); bf16_t* WgT = (bf16_t*)(ws + WS_WG);
    bf16_t* WupT = (bf16_t*)(ws + WS_WUP); bf16_t* WoutT = (bf16_t*)(ws + WS_WOUT); bf16_t* W1T = (bf16_t*)(ws + WS_W1); bf16_t* W2T = (bf16_t*)(ws + WS_W2);
    bf16_t* Z0 = (bf16_t*)(ws + WS_Z); bf16_t* UP = (bf16_t*)(ws + WS_UP); bf16_t* UL = (bf16_t*)(ws + WS_UL); bf16_t* GGb = (bf16_t*)(ws + WS_GG);
    bf16_t* GAb = (bf16_t*)(ws + WS_GA); bf16_t* GBb = (bf16_t*)(ws + WS_GB);
    bf16_t* Db = (bf16_t*)(ws + WS_D); bf16_t* XCb = (bf16_t*)(ws + WS_XC); bf16_t* YY = (bf16_t*)(ws + WS_YY); bf16_t* Mb = (bf16_t*)(ws + WS_MB);
    float* V1 = (float*)(ws + WS_V1); float* X1 = (float*)(ws + WS_X1); bf16_t* X1B = (bf16_t*)(ws + WS_X1B); bf16_t* Hb = (bf16_t*)(ws + WS_H); float* V2 = (float*)(ws + WS_V2);
    float* KC = (float*)(ws + WS_KC); f32x2* AGG = (f32x2*)(ws + WS_AGG);
    const int lo = a.ph_lo, hi = a.ph_hi;
    if (lo < 0) cg::this_grid().sync();
    volatile LAS unsigned* misc = (volatile LAS unsigned*)(lds + LDS_MISC);
    if (threadIdx.x < 2) misc[threadIdx.x] = 0u;
    __syncthreads();
    const XcdBarrier gbar = xcd_barrier_post((unsigned*)(ws + WS_BAR), misc);
#ifndef PH_MASK
#define PH_MASK 0x7ff
#endif
#define IN(k) (((PH_MASK >> (k)) & 1) && lo <= (k) && (k) < hi)
#define SEAM(k) do { if (IN(k) && IN((k) + 1)) xcd_barrier(gbar); } while (0)

    if (IN(0)) {
        THREAD_IDS();
        constexpr int I_IN = 32 * 160, I_POOL = 4 * 64, I_G = 32 * 16, I_UP = 1024, I_OUT = 1024;
        constexpr int NITEMS = I_IN + I_POOL + I_G + 2 * I_UP + I_OUT;
        for (int it = gw; it < NITEMS; it += NGW) {
            int r = it;
            if (r < I_IN) { transpose_matrix(a.w_in, DM, NIN, WinT, DM, r, scr, lane); continue; } r -= I_IN;
            if (r < I_POOL) { const int g = r >> 6; transpose_matrix(a.pool_w + (size_t)g * 512 * 512, 512, 512, PoolT + (size_t)g * 512 * 512, 512, r & 63, scr, lane); continue; } r -= I_POOL;
            if (r < I_G) { const int mat = r >> 4, sub = r & 15, h = mat & 7, gate = (mat >> 3) & 1, dir = mat >> 4;
                const float* S = (gate ? a.lru_wx : a.lru_wa) + (size_t)(dir * 8 + h) * 256 * 256;
                transpose_item(S, 256, WgT + (size_t)h * 4 * 256 * 256, 256, (sub >> 2) * 64, (sub & 3) * 64, 1, 128 * dir + 16 * gate, scr, lane); continue; } r -= I_G;
            if (r < I_UP) { transpose_matrix(a.w_pool_up, DM, DM, WupT, 2 * DM, r, scr, lane); continue; } r -= I_UP;
            if (r < I_UP) { transpose_matrix(a.w_lru_up, DM, DM, WupT + DM, 2 * DM, r, scr, lane); continue; } r -= I_UP;
            transpose_matrix(a.w_out, DM, DM, WoutT, DM, r, scr, lane);
        }
        for (int i = gt; i < MT * DM / 8; i += NT) {
            const f32x4 v0 = *((const f32x4*)a.x + 2 * (size_t)i), v1 = *((const f32x4*)a.x + 2 * (size_t)i + 1);
            u32x4 w; w.x = pg8::cvt_pk_bf16(v0[0], v0[1]); w.y = pg8::cvt_pk_bf16(v0[2], v0[3]); w.z = pg8::cvt_pk_bf16(v1[0], v1[1]); w.w = pg8::cvt_pk_bf16(v1[2], v1[3]);
            *((u32x4*)XB + i) = w;
        }
        if (gt < 2 * DM) KC[gt] = -8.0f * 1.44269504f * log1pf(expf(-a.lru_lambda[gt]));
    }
    SEAM(0);
    if (IN(1)) {
        pg8::Gemm g{XB, WinT, DM, DM, DM / 64, 1, 0}; pg8::StaticOrder S; S.init(32, NIN / 256, G, bx);
        pg8::EpiZ E{Z0};
        pg8::gemm_phase<pg8::EpiZ>(lds, g, S, E);
    }
    SEAM(1);
    if (IN(2)) {
        THREAD_IDS();
        for (int item = gt; item < 512 * 512; item += NT) {
            const int chunk = item & 511, run = item >> 9;
            const int row0 = run * 16, t0 = row0 & (SEQ - 1), rowb = row0 - t0;
            if (chunk < 256) {
                const int c0 = chunk * 8, h = 1 << (chunk >> 6);
                const bf16_t* U = UP + (size_t)rowb * DM + c0;
                float sum[8];
#pragma unroll
                for (int e = 0; e < 8; ++e) sum[e] = 0.f;
                for (int s = t0 - h; s < t0 + h; ++s) if (s >= 0 && s < SEQ) { const u32x4 w = *(const u32x4*)(U + (size_t)s * DM);
                    sum[0] += pg8::bf_lo(w.x); sum[1] += pg8::bf_hi(w.x); sum[2] += pg8::bf_lo(w.y); sum[3] += pg8::bf_hi(w.y); sum[4] += pg8::bf_lo(w.z); sum[5] += pg8::bf_hi(w.z); sum[6] += pg8::bf_lo(w.w); sum[7] += pg8::bf_hi(w.w); }
                for (int i = 0; i < 16; ++i) {
                    const int t = t0 + i; const int lo_ = t - h < 0 ? 0 : t - h, hi_ = t + h > SEQ ? SEQ : t + h;
                    const float inv = 1.0f / (float)(hi_ - lo_);
                    const u32x4 w = *(const u32x4*)(U + (size_t)t * DM);
                    u32x4 o;
                    o.x = pg8::cvt_pk_bf16(sum[0] * inv - pg8::bf_lo(w.x), sum[1] * inv - pg8::bf_hi(w.x)); o.y = pg8::cvt_pk_bf16(sum[2] * inv - pg8::bf_lo(w.y), sum[3] * inv - pg8::bf_hi(w.y));
                    o.z = pg8::cvt_pk_bf16(sum[4] * inv - pg8::bf_lo(w.z), sum[5] * inv - pg8::bf_hi(w.z)); o.w = pg8::cvt_pk_bf16(sum[6] * inv - pg8::bf_lo(w.w), sum[7] * inv - pg8::bf_hi(w.w));
                    *(u32x4*)(Db + (size_t)(rowb + t) * DM + c0) = o;
                    if (t + h < SEQ) { const u32x4 q = *(const u32x4*)(U + (size_t)(t + h) * DM);
                        sum[0] += pg8::bf_lo(q.x); sum[1] += pg8::bf_hi(q.x); sum[2] += pg8::bf_lo(q.y); sum[3] += pg8::bf_hi(q.y); sum[4] += pg8::bf_lo(q.z); sum[5] += pg8::bf_hi(q.z); sum[6] += pg8::bf_lo(q.w); sum[7] += pg8::bf_hi(q.w); }
                    if (t - h >= 0) { const u32x4 q = *(const u32x4*)(U + (size_t)(t - h) * DM);
                        sum[0] -= pg8::bf_lo(q.x); sum[1] -= pg8::bf_hi(q.x); sum[2] -= pg8::bf_lo(q.y); sum[3] -= pg8::bf_hi(q.y); sum[4] -= pg8::bf_lo(q.z); sum[5] -= pg8::bf_hi(q.z); sum[6] -= pg8::bf_lo(q.w); sum[7] -= pg8::bf_hi(q.w); }
                }
            } else {
                const int c0 = (chunk - 256) * 8;
                const bf16_t* U = UL + (size_t)rowb * DM + c0;
                f32x4 w0[4], w1[4];
#pragma unroll
                for (int k = 0; k < 4; ++k) { w0[k] = *(const f32x4*)(a.conv_w + k * DM + c0); w1[k] = *(const f32x4*)(a.conv_w + k * DM + c0 + 4); }
                const f32x4 b0 = *(const f32x4*)(a.conv_b + c0), b1 = *(const f32x4*)(a.conv_b + c0 + 4);
                const u32x4 zz = (u32x4){0u, 0u, 0u, 0u};
                u32x4 r0 = (t0 - 2 >= 0) ? *(const u32x4*)(U + (size_t)(t0 - 2) * DM) : zz;
                u32x4 r1 = (t0 - 1 >= 0) ? *(const u32x4*)(U + (size_t)(t0 - 1) * DM) : zz;
                u32x4 r2 = *(const u32x4*)(U + (size_t)t0 * DM);
                for (int i = 0; i < 16; ++i) {
                    const int t = t0 + i;
                    const u32x4 r3 = (t + 1 < SEQ) ? *(const u32x4*)(U + (size_t)(t + 1) * DM) : zz;
                    f32x4 y0 = b0, y1 = b1;
#define CONV_TAP(rk, k) do { y0 += (f32x4){pg8::bf_lo(rk.x), pg8::bf_hi(rk.x), pg8::bf_lo(rk.y), pg8::bf_hi(rk.y)} * w0[k]; y1 += (f32x4){pg8::bf_lo(rk.z), pg8::bf_hi(rk.z), pg8::bf_lo(rk.w), pg8::bf_hi(rk.w)} * w1[k]; } while (0)
                    CONV_TAP(r0, 0); CONV_TAP(r1, 1); CONV_TAP(r2, 2); CONV_TAP(r3, 3);
#undef CONV_TAP
                    u32x4 o; o.x = pg8::cvt_pk_bf16(y0[0], y0[1]); o.y = pg8::cvt_pk_bf16(y0[2], y0[3]); o.z = pg8::cvt_pk_bf16(y1[0], y1[1]); o.w = pg8::cvt_pk_bf16(y1[2], y1[3]);
                    *(u32x4*)(XCb + (size_t)(rowb + t) * DM + c0) = o;
                    r0 = r1; r1 = r2; r2 = r3;
                }
            }
        }
        for (int it = gw; it < 32 * 128; it += NGW) transpose_matrix(a.w_ff1, DM, FF, W1T, DM, it, scr, lane);
    }
    SEAM(2);
    if (IN(3)) {
        { pg8::Gemm g{Db, PoolT, DM, 512, 8, 2, 512}; pg8::StaticOrder S; S.init(32, 8, G, bx);
          pg8::EpiB<0> E{YY, 2 * DM, a.pool_scale};
          pg8::gemm_phase<pg8::EpiB<0>>(lds, g, S, E); }
        { pg8::Gemm g{XCb, WgT, DM, 256, 4, 4, 256}; pg8::StaticOrder S; S.init(32, 32, G, bx);
          pg8::EpiGate<1> E{XCb, GGb, YY, a.lru_ba, a.lru_bx, KC, AGG};
          pg8::gemm_phase<pg8::EpiGate<1>>(lds, g, S, E); }
    }
    SEAM(3);
    if (IN(4)) {
        pg8::Gemm g{XCb, WgT, DM, 256, 4, 4, 256}; pg8::StaticOrder S; S.init(32, 32, G, bx);
        pg8::EpiGate<2> E{XCb, GGb, YY, a.lru_ba, a.lru_bx, KC, AGG};
        pg8::gemm_phase<pg8::EpiGate<2>>(lds, g, S, E);
    }
    SEAM(4);
    if (IN(5)) {
        pg8::Gemm g{YY, WupT, 2 * DM, 2 * DM, 2 * DM / 64, 1, 0}; pg8::StaticOrder S; S.init(32, 8, G, bx);
        pg8::EpiMerge E{GAb, GBb, Mb};
        pg8::gemm_phase<pg8::EpiMerge>(lds, g, S, E);
    }
    SEAM(5);
    if (IN(6)) {
        pg8::Gemm g{Mb, WoutT, DM, DM, DM / 64, 1, 0}; pg8::StaticOrder S; S.init(32, 8, G, bx);
        pg8::EpiRes E{a.x, V1, a.b_out, DN_ALPHA};
        pg8::gemm_phase<pg8::EpiRes>(lds, g, S, E);
    }
    SEAM(6);
    if (IN(7)) {
        THREAD_IDS();
        ln_rows(V1, a.ln1_g, a.ln1_b, X1, X1B, gw, NGW, lane);
        for (int it = gw; it < 128 * 32; it += NGW) transpose_matrix(a.w_ff2, FF, DM, W2T, FF, it, scr, lane);
    }
    SEAM(7);
    if (IN(8)) {
        pg8::Gemm g{X1B, W1T, DM, DM, DM / 64, 1, 0}; pg8::StaticOrder S; S.init(32, FF / 256, G, bx);
        pg8::EpiB<1> E{Hb, FF, a.b_ff1};
        pg8::gemm_phase<pg8::EpiB<1>>(lds, g, S, E);
    }
    SEAM(8);
    if (IN(9)) {
        pg8::Gemm g{Hb, W2T, FF, FF, FF / 64, 1, 0}; pg8::StaticOrder S; S.init(32, 8, G, bx);
        pg8::EpiRes E{X1, V2, a.b_ff2, DN_ALPHA};
        pg8::gemm_phase<pg8::EpiRes>(lds, g, S, E);
    }
    SEAM(9);
    if (IN(10)) { THREAD_IDS(); ln_rows(V2, a.ln2_g, a.ln2_b, a.out, nullptr, gw, NGW, lane); }
#undef IN
#undef SEAM
}

extern "C" void kernel_launch(void* const* d_in, const int* in_sizes, int n_in, void* d_out, int out_size, void* d_ws, size_t ws_size, hipStream_t stream) {
    static int grid = 0;
    if (grid == 0) {
        if (n_in != 23 || in_sizes[0] != MT * DM || out_size != MT * DM || ws_size < WS_END) { fprintf(stderr, "kernel_launch: unexpected shapes (n_in %d, ws %zu)\n", n_in, ws_size); grid = -1; return; }
        int dev = 0, cus = 0, per_cu = 0;
        hipGetDevice(&dev); hipDeviceGetAttribute(&cus, hipDeviceAttributeMultiprocessorCount, dev);
        if (hipFuncSetAttribute((const void*)fwd_kernel, hipFuncAttributeMaxDynamicSharedMemorySize, LDS_BYTES) != hipSuccess) { fprintf(stderr, "kernel_launch: hipFuncSetAttribute failed\n"); grid = -1; return; }
        hipOccupancyMaxActiveBlocksPerMultiprocessor(&per_cu, (const void*)fwd_kernel, 512, LDS_BYTES);
        (void)hipGetLastError();
        if (per_cu < 1) per_cu = 1;
        grid = cus * per_cu;
        if (grid > 256) grid = 256;
    }
    if (grid < 0) return;
    if (hipMemsetAsync((char*)d_ws + WS_BAR, 0, WS_BAR_BYTES, stream) != hipSuccess) { fprintf(stderr, "kernel_launch: memset failed\n"); return; }
    Args a{};
    const float** ap = (const float**)&a;
    for (int i = 0; i < 23; ++i) ap[i] = (const float*)d_in[i];
    a.out = (float*)d_out; a.ws = (unsigned char*)d_ws;
#if MK_N_LAUNCHES == 1
    a.ph_lo = 0; a.ph_hi = NPHASE;
    void* args[] = {&a};
    hipError_t e = hipLaunchCooperativeKernel((const void*)fwd_kernel, dim3(grid), dim3(512), args, LDS_BYTES, stream);
    if (e != hipSuccess) fprintf(stderr, "cooperative launch failed: %s (grid %d)\n", hipGetErrorString(e), grid);
#else
    for (int p = 0; p < NPHASE; ++p) { a.ph_lo = p; a.ph_hi = p + 1; hipLaunchKernelGGL(fwd_kernel, dim3(grid), dim3(512), LDS_BYTES, stream, a); }
#endif
}
```

```cpp
#include <hip/hip_runtime.h>
#include <hip/hip_cooperative_groups.h>
#include <cstdio>
#include <cstdint>
namespace cg = cooperative_groups;

#ifndef MK_N_LAUNCHES
#define MK_N_LAUNCHES 1
#endif

namespace pg8 {
#define PG8_LAS __attribute__((address_space(3)))
typedef unsigned short bf16_t;
typedef short bf16x8 __attribute__((ext_vector_type(8)));
typedef float f32x4 __attribute__((ext_vector_type(4)));
typedef float f32x2 __attribute__((ext_vector_type(2)));
typedef unsigned u32x4 __attribute__((ext_vector_type(4)));
typedef unsigned u32x2 __attribute__((ext_vector_type(2)));
constexpr int BM = 256, BK = 64, HALF = 128, HTB = HALF * BK * 2, STAGE_BYTES = 8 * HTB, NXCD = 8, WGM = 8;

__host__ __device__ __forceinline__ int lds_byte(int r, int c) { const int st = (r >> 4) * 2 + (c >> 5), rr = r & 15, cc = c & 31, ob = rr * 64 + cc * 2; return st * 1024 + (ob ^ (((ob >> 9) & 1) << 5)); }
__host__ __device__ __forceinline__ void stage_rc(int b, int& R, int& C) { const int st = b / 1024, sb = b % 1024, swz = sb ^ (((sb >> 9) & 1) << 5); R = (st >> 1) * 16 + swz / 64; C = (st & 1) * 32 + (swz % 64) / 2; }
__host__ __device__ __forceinline__ int perm32(int rho) { const int n = rho >> 4, i = rho & 15; return 8 * (i >> 2) + 4 * n + (i & 3); }

struct Unit { int pm, pn; };
struct Gemm { const bf16_t* A; const bf16_t* Bt; int lda, ldb, nt, adiv, astride; };

struct StaticOrder {
    int nM, nN, nwg, G, c;
    __device__ void init(int nM_, int nN_, int G_, int c_) { nM = nM_; nN = nN_; nwg = nM * nN; G = G_; c = c_; }
    __device__ bool next(int i, Unit& u) const {
        const long L = (long)i * G + c; if (L >= nwg) return false;
        int wgid = (int)L; { const int q = nwg / NXCD, r = nwg % NXCD, xcd = wgid % NXCD, off = wgid / NXCD; wgid = (xcd < r ? xcd * (q + 1) : r * (q + 1) + (xcd - r) * q) + off; }
        const int nig = WGM * nN, gid = wgid / nig, fm = gid * WGM, gsz = (nM - fm) < WGM ? (nM - fm) : WGM;
        u.pm = fm + ((wgid % nig) % gsz); u.pn = (wgid % nig) / gsz; return true;
    }
};

__device__ __forceinline__ unsigned cvt_pk_bf16(float lo, float hi) { unsigned r; asm volatile("v_cvt_pk_bf16_f32 %0, %1, %2" : "=v"(r) : "v"(lo), "v"(hi)); return r; }
__device__ __forceinline__ float bf_lo(unsigned w) { return __builtin_bit_cast(float, w << 16); }
__device__ __forceinline__ float bf_hi(unsigned w) { return __builtin_bit_cast(float, w & 0xffff0000u); }
__device__ __forceinline__ float fsigmoid(float v) { return __builtin_amdgcn_rcpf(1.0f + __builtin_amdgcn_exp2f(-1.44269504f * v)); }
__device__ __forceinline__ float gelu_tanh(float v) { const float y = v * (1.0f + 0.044715f * v * v); return v * __builtin_amdgcn_rcpf(1.0f + __builtin_amdgcn_exp2f(-2.30220819f * y)); }
template <int CTRL> __device__ __forceinline__ float dpp(float old, float src) {
    return __builtin_bit_cast(float, __builtin_amdgcn_update_dpp(__builtin_bit_cast(int, old), __builtin_bit_cast(int, src), CTRL, 0xf, 0xf, false));
}
#define EPI_BAR() do { asm volatile("s_waitcnt lgkmcnt(0)" ::: "memory"); __builtin_amdgcn_s_barrier(); asm volatile("" ::: "memory"); } while (0)

typedef f32x4 Acc[2][2][4][2];
constexpr int MT = 8192, DM = 2048;

struct EpiZ {
    static constexpr bool PERM = true, MID = false, APERM = false;
    bf16_t* Z0;
    __device__ __forceinline__ void operator()(Acc& acc, const Unit& u, int wr, int wc, int fr, int fq, PG8_LAS unsigned char*) const {
        const int region = u.pn >> 3;
        bf16_t* base = Z0 + (size_t)region * ((size_t)MT * DM) + (size_t)(u.pm * BM + wr * 64 + fr) * DM + (u.pn & 7) * BM + wc * 32 + 8 * fq;
#pragma unroll
        for (int ai = 0; ai < 2; ++ai)
#pragma unroll
            for (int m = 0; m < 4; ++m) { bf16_t* rowp = base + (size_t)(ai * HALF + m * 16) * DM;
#pragma unroll
                for (int bj = 0; bj < 2; ++bj) { f32x4 v0 = acc[ai][bj][m][0], v1 = acc[ai][bj][m][1];
                    if (region == 2) {
#pragma unroll
                        for (int e = 0; e < 4; ++e) { v0[e] = gelu_tanh(v0[e]); v1[e] = gelu_tanh(v1[e]); }
                    } else if (region >= 3) {
#pragma unroll
                        for (int e = 0; e < 4; ++e) { v0[e] = fsigmoid(v0[e]); v1[e] = fsigmoid(v1[e]); }
                    }
                    u32x4 w; w.x = cvt_pk_bf16(v0[0], v0[1]); w.y = cvt_pk_bf16(v0[2], v0[3]); w.z = cvt_pk_bf16(v1[0], v1[1]); w.w = cvt_pk_bf16(v1[2], v1[3]);
                    *(u32x4*)(rowp + bj * HALF) = w; } }
    }
};
template <int MODE> struct EpiB {
    static constexpr bool PERM = true, MID = false, APERM = false;
    bf16_t* O; int ldc; const float* vec;
    __device__ __forceinline__ void operator()(Acc& acc, const Unit& u, int wr, int wc, int fr, int fq, PG8_LAS unsigned char*) const {
        const int col0 = u.pn * BM + wc * 32 + 8 * fq;
        f32x4 bv[2][2];
#pragma unroll
        for (int bj = 0; bj < 2; ++bj)
#pragma unroll
            for (int n = 0; n < 2; ++n) bv[bj][n] = *(const f32x4*)(vec + col0 + bj * HALF + 4 * n);
        bf16_t* base = O + (size_t)(u.pm * BM + wr * 64 + fr) * ldc + col0;
#pragma unroll
        for (int ai = 0; ai < 2; ++ai)
#pragma unroll
            for (int m = 0; m < 4; ++m) { bf16_t* rowp = base + (size_t)(ai * HALF + m * 16) * ldc;
#pragma unroll
                for (int bj = 0; bj < 2; ++bj) { f32x4 v0, v1;
                    if (MODE == 0) { v0 = acc[ai][bj][m][0] * bv[bj][0]; v1 = acc[ai][bj][m][1] * bv[bj][1]; }
                    else { v0 = acc[ai][bj][m][0] + bv[bj][0]; v1 = acc[ai][bj][m][1] + bv[bj][1];
#pragma unroll
                        for (int e = 0; e < 4; ++e) { const float a = fmaxf(v0[e], 0.f), b = fmaxf(v1[e], 0.f); v0[e] = a * a; v1[e] = b * b; } }
                    u32x4 w; w.x = cvt_pk_bf16(v0[0], v0[1]); w.y = cvt_pk_bf16(v0[2], v0[3]); w.z = cvt_pk_bf16(v1[0], v1[1]); w.w = cvt_pk_bf16(v1[2], v1[3]);
                    *(u32x4*)(rowp + bj * HALF) = w; } }
    }
};
struct EpiMerge {
    static constexpr bool PERM = true, MID = true, APERM = false;
    const bf16_t* GA; const bf16_t* GB; bf16_t* O;
    __device__ __forceinline__ void mid(Acc& acc, const Unit& u, int wr, int wc, int fr, int fq) const {
        const size_t off0 = (size_t)(u.pm * BM + wr * 64 + fr) * DM + u.pn * BM + wc * 32 + 8 * fq;
#pragma unroll
        for (int ai = 0; ai < 2; ++ai)
#pragma unroll
            for (int m = 0; m < 4; ++m) {
#pragma unroll
                for (int bj = 0; bj < 2; ++bj) { const size_t off = off0 + (size_t)(ai * HALF + m * 16) * DM + bj * HALF;
                    const u32x4 a = *(const u32x4*)(GA + off), b = *(const u32x4*)(GB + off);
                    f32x4 r0, r1;
                    r0[0] = bf_lo(a.x) * __builtin_amdgcn_rcpf(bf_lo(b.x)); r0[1] = bf_hi(a.x) * __builtin_amdgcn_rcpf(bf_hi(b.x));
                    r0[2] = bf_lo(a.y) * __builtin_amdgcn_rcpf(bf_lo(b.y)); r0[3] = bf_hi(a.y) * __builtin_amdgcn_rcpf(bf_hi(b.y));
                    r1[0] = bf_lo(a.z) * __builtin_amdgcn_rcpf(bf_lo(b.z)); r1[1] = bf_hi(a.z) * __builtin_amdgcn_rcpf(bf_hi(b.z));
                    r1[2] = bf_lo(a.w) * __builtin_amdgcn_rcpf(bf_lo(b.w)); r1[3] = bf_hi(a.w) * __builtin_amdgcn_rcpf(bf_hi(b.w));
                    acc[ai][bj][m][0] *= r0; acc[ai][bj][m][1] *= r1; }
                if (m & 1) asm volatile("" ::: "memory"); }
    }
    __device__ __forceinline__ void operator()(Acc& acc, const Unit& u, int wr, int wc, int fr, int fq, PG8_LAS unsigned char*) const {
        const size_t off0 = (size_t)(u.pm * BM + wr * 64 + fr) * DM + u.pn * BM + wc * 32 + 8 * fq;
#pragma unroll
        for (int ai = 0; ai < 2; ++ai)
#pragma unroll
            for (int m = 0; m < 4; ++m) {
#pragma unroll
                for (int bj = 0; bj < 2; ++bj) { const size_t off = off0 + (size_t)(ai * HALF + m * 16) * DM + bj * HALF;
                    const u32x4 b = *(const u32x4*)(GB + off);
                    const f32x4 v0 = acc[ai][bj][m][0], v1 = acc[ai][bj][m][1];
                    u32x4 w; w.x = cvt_pk_bf16(v0[0] * bf_lo(b.x), v0[1] * bf_hi(b.x)); w.y = cvt_pk_bf16(v0[2] * bf_lo(b.y), v0[3] * bf_hi(b.y));
                    w.z = cvt_pk_bf16(v1[0] * bf_lo(b.z), v1[1] * bf_hi(b.z)); w.w = cvt_pk_bf16(v1[2] * bf_lo(b.w), v1[3] * bf_hi(b.w));
                    *(u32x4*)(O + off) = w; }
                if (m & 1) asm volatile("" ::: "memory"); }
    }
};
struct EpiRes {
    static constexpr bool PERM = false, MID = false, APERM = false;
    const float* base; float* out; const float* bias; float alpha;
    __device__ __forceinline__ void operator()(Acc& acc, const Unit& u, int wr, int wc, int fr, int fq, PG8_LAS unsigned char*) const {
        const int col0 = u.pn * BM + wc * 32 + 4 * fq;
        f32x4 bv[2][2];
#pragma unroll
        for (int bj = 0; bj < 2; ++bj)
#pragma unroll
            for (int n = 0; n < 2; ++n) bv[bj][n] = *(const f32x4*)(bias + col0 + bj * HALF + n * 16);
        const size_t off0 = (size_t)(u.pm * BM + wr * 64 + fr) * DM + col0;
#pragma unroll
        for (int ai = 0; ai < 2; ++ai)
#pragma unroll
            for (int m = 0; m < 4; ++m) { const size_t off = off0 + (size_t)(ai * HALF + m * 16) * DM;
#pragma unroll
                for (int bj = 0; bj < 2; ++bj)
#pragma unroll
                    for (int n = 0; n < 2; ++n) { const f32x4 bs = *(const f32x4*)(base + off + bj * HALF + n * 16);
                        *(f32x4*)(out + off + bj * HALF + n * 16) = bs * alpha + acc[ai][bj][m][n] + bv[bj][n]; }
                asm volatile("" ::: "memory"); }
    }
};
#define GATE_SCAN(SHIFT, a, b) do { float ap_, bp_; \
    ap_ = dpp<SHIFT + 1>(1.0f, a); bp_ = dpp<SHIFT + 1>(0.0f, b); b = a * bp_ + b; a = a * ap_; \
    ap_ = dpp<SHIFT + 2>(1.0f, a); bp_ = dpp<SHIFT + 2>(0.0f, b); b = a * bp_ + b; a = a * ap_; \
    ap_ = dpp<SHIFT + 4>(1.0f, a); bp_ = dpp<SHIFT + 4>(0.0f, b); b = a * bp_ + b; a = a * ap_; \
    ap_ = dpp<SHIFT + 8>(1.0f, a); bp_ = dpp<SHIFT + 8>(0.0f, b); b = a * bp_ + b; a = a * ap_; } while (0)
template <int PASS> struct EpiGate {
    static constexpr bool PERM = false, MID = false, APERM = true;
    const bf16_t* XC; const bf16_t* GG; bf16_t* YY; const float* BA; const float* BX; const float* KC; f32x2* AGG;
    __device__ __forceinline__ void operator()(Acc& acc, const Unit& u, int wr, int wc, int fr, int fq, PG8_LAS unsigned char* ldsx) const {
        const int tid = (wr * 4 + wc) * 64 + fq * 16 + fr;
        const int chb = u.pn * 64, cl = wc * 16 + fq * 4, ch0 = chb + cl;
        PG8_LAS float* GS = (PG8_LAS float*)ldsx;
        if (PASS == 2) {
            const int s = tid >> 7, d = (tid >> 6) & 1, c = tid & 63;
            const int sg = u.pm * 4 + s, b0 = sg & ~63;
            const f32x2* ag = AGG + (size_t)d * DM + chb + c;
            float cy = 0.f;
            const int n = d == 0 ? sg - b0 : b0 + 63 - sg, p0 = d == 0 ? b0 : b0 + 63, st = d == 0 ? 1 : -1;
            for (int i0 = 0; i0 < n; i0 += 16) {
                f32x2 v[16];
#pragma unroll
                for (int j = 0; j < 16; ++j) { const int i = i0 + j < n ? i0 + j : n - 1; v[j] = ag[(size_t)(p0 + st * i) * (2 * DM)]; }
#pragma unroll
                for (int j = 0; j < 16; ++j) { if (i0 + j < n) cy = v[j].x * cy + v[j].y; }
            }
            GS[tid] = cy;
            EPI_BAR();
        }
        const unsigned rbase = (unsigned)((u.pm * BM + wr * 64 + 4 * fr) * DM + ch0);
#define GATE_ELEM(ai, d) do { \
            int cho_ = (d) * DM + ch0; asm volatile("" : "+v"(cho_)); \
            const f32x4 ba_ = *(const f32x4*)(BA + cho_), bx_ = *(const f32x4*)(BX + cho_), kc_ = *(const f32x4*)(KC + cho_); \
            _Pragma("unroll") for (int m = 0; m < 4; ++m) { \
                f32x4 xv; xv[0] = bf_lo(xw[m].x); xv[1] = bf_hi(xw[m].x); xv[2] = bf_lo(xw[m].y); xv[3] = bf_hi(xw[m].y); \
                _Pragma("unroll") for (int e = 0; e < 4; ++e) { \
                    const float r = fsigmoid(acc[ai][d][m][0][e] + ba_[e]); \
                    const float ig = fsigmoid(acc[ai][d][m][1][e] + bx_[e]); \
                    const float a = __builtin_amdgcn_exp2f(kc_[e] * r); \
                    const float sq = __builtin_amdgcn_sqrtf(fmaxf(1.0f - a * a, 0.f)); \
                    acc[ai][d][m][0][e] = a; acc[ai][d][m][1][e] = sq * (ig * xv[e]); } \
                __builtin_amdgcn_sched_barrier(0); } } while (0)
#pragma unroll
        for (int ai = 0; ai < 2; ++ai) {
            const int s = 2 * ai + wr;
            f32x4 cf = (f32x4){0.f, 0.f, 0.f, 0.f}, cb = cf, Af = (f32x4){1.f, 1.f, 1.f, 1.f}, Ab = Af;
            u32x2 xw[4], gw[4];
#pragma unroll
            for (int m = 0; m < 4; ++m) { unsigned xoff = rbase + (unsigned)((ai * HALF + m) * DM); asm volatile("" : "+v"(xoff)); xw[m] = *(const u32x2*)(XC + xoff); if (PASS == 2) gw[m] = *(const u32x2*)(GG + xoff); }
            GATE_ELEM(ai, 0);
            if (PASS == 2) cf = *(const PG8_LAS f32x4*)(GS + (s * 2 + 0) * 64 + cl);
#pragma unroll
            for (int e = 0; e < 4; ++e) {
#pragma unroll
                for (int m = 1; m < 4; ++m) { acc[ai][0][m][1][e] = acc[ai][0][m][0][e] * acc[ai][0][m - 1][1][e] + acc[ai][0][m][1][e]; acc[ai][0][m][0][e] *= acc[ai][0][m - 1][0][e]; }
                float P = acc[ai][0][3][0][e], Q = acc[ai][0][3][1][e];
                GATE_SCAN(0x110, P, Q);
                const float st = P * cf[e] + Q;
                if (PASS == 1) { Af[e] = dpp<0x15F>(0.f, P); cf[e] = dpp<0x15F>(0.f, st); }
                else {
                    const float cin = dpp<0x111>(cf[e], st);
#pragma unroll
                    for (int m = 0; m < 4; ++m) acc[ai][0][m][1][e] = acc[ai][0][m][0][e] * cin + acc[ai][0][m][1][e];
                }
            }
            __builtin_amdgcn_sched_barrier(0);
            GATE_ELEM(ai, 1);
            if (PASS == 2) cb = *(const PG8_LAS f32x4*)(GS + (s * 2 + 1) * 64 + cl);
#pragma unroll
            for (int e = 0; e < 4; ++e) {
#pragma unroll
                for (int m = 2; m >= 0; --m) { acc[ai][1][m][1][e] = acc[ai][1][m][0][e] * acc[ai][1][m + 1][1][e] + acc[ai][1][m][1][e]; acc[ai][1][m][0][e] *= acc[ai][1][m + 1][0][e]; }
                float P = acc[ai][1][0][0][e], Q = acc[ai][1][0][1][e];
                GATE_SCAN(0x100, P, Q);
                const float st = P * cb[e] + Q;
                if (PASS == 1) { Ab[e] = dpp<0x150>(0.f, P); cb[e] = dpp<0x150>(0.f, st); }
                else {
                    const float cin = dpp<0x101>(cb[e], st);
#pragma unroll
                    for (int m = 0; m < 4; ++m) acc[ai][1][m][1][e] = acc[ai][1][m][0][e] * cin + acc[ai][1][m][1][e];
                }
            }
            __builtin_amdgcn_sched_barrier(0);
            if (PASS == 2) {
#pragma unroll
                for (int m = 0; m < 4; ++m) {
                    unsigned goff = rbase + (unsigned)((ai * HALF + m) * DM); asm volatile("" : "+v"(goff));
                    const unsigned yoff = 2u * goff - (unsigned)ch0 + (unsigned)DM;
                    f32x4 gv; gv[0] = bf_lo(gw[m].x); gv[1] = bf_hi(gw[m].x); gv[2] = bf_lo(gw[m].y); gv[3] = bf_hi(gw[m].y);
                    const f32x4 y = (acc[ai][0][m][1] + acc[ai][1][m][1]) * gv;
                    u32x2 w; w.x = cvt_pk_bf16(y[0], y[1]); w.y = cvt_pk_bf16(y[2], y[3]);
                    *(u32x2*)(YY + yoff) = w;
                }
                asm volatile("" ::: "memory"); __builtin_amdgcn_sched_barrier(0);
            }
            if (PASS == 1) {
                f32x2* ag = AGG + (size_t)(u.pm * 4 + s) * (2 * DM) + ch0;
                if (fr == 15) { *(f32x4*)(ag) = (f32x4){Af[0], cf[0], Af[1], cf[1]}; *(f32x4*)(ag + 2) = (f32x4){Af[2], cf[2], Af[3], cf[3]}; }
                if (fr == 0) { *(f32x4*)(ag + DM) = (f32x4){Ab[0], cb[0], Ab[1], cb[1]}; *(f32x4*)(ag + DM + 2) = (f32x4){Ab[2], cb[2], Ab[3], cb[3]}; }
            }
        }
    }
};

template <class Epi>
__device__ __forceinline__ void gemm_phase(PG8_LAS unsigned char* lds, const Gemm g, const StaticOrder& S, const Epi& E) {
    const int tid = threadIdx.x, wid = __builtin_amdgcn_readfirstlane(tid >> 6), lane = tid & 63, wr = wid >> 2, wc = wid & 3, fr = lane & 15, fq = lane >> 4;
    const int nt = g.nt;
    unsigned voffA[2], voffB[2];
#pragma unroll
    for (int i = 0; i < 2; ++i) { int R, C; stage_rc(tid * 16 + i * 8192, R, C); const int Rb = Epi::PERM ? ((R & ~31) + perm32(R & 31)) : R;
        const int Ra = Epi::APERM ? ((R & 64) | ((R & 15) << 2) | ((R >> 4) & 3)) : R;
        voffA[i] = (unsigned)(Ra * g.lda + C) * 2u; voffB[i] = (unsigned)(Rb * g.ldb + C) * 2u; }
    const size_t kstep = (size_t)(BK * 2);
    const size_t hstepA = (size_t)HALF * g.lda * 2, hstepB = (size_t)HALF * g.ldb * 2;
    const unsigned ldsw = (unsigned)wid * 1024u;
    const int aoff = lds_byte(wr * 64 + fr, fq * 8), boff = lds_byte(wc * 32 + fr, fq * 8);
    PG8_LAS unsigned char* ldsx = lds + STAGE_BYTES;
#define PG8_UA(u) ((const char*)g.A + ((size_t)(u).pm * BM * g.lda + (size_t)((u).pn / g.adiv) * g.astride) * 2)
#define PG8_UB(u) ((const char*)g.Bt + (size_t)(u).pn * BM * g.ldb * 2)
#define PG8_SA(b, h) (((b) * 2 + (h)) * HTB)
#define PG8_SB(b, h) ((4 + (b) * 2 + (h)) * HTB)
#define PG8_STAGE(bufoff, gbase, voff) do { _Pragma("unroll") for (int _i = 0; _i < 2; ++_i) \
        __builtin_amdgcn_global_load_lds((const unsigned*)((const char*)(gbase) + (voff)[_i]), (PG8_LAS unsigned*)(lds + (bufoff) + ldsw + _i * 8192), 16, 0, 0); } while (0)
#define PG8_LDA(dst, b, h) do { _Pragma("unroll") for (int m = 0; m < 4; ++m) _Pragma("unroll") for (int k = 0; k < 2; ++k) dst[m][k] = *(const PG8_LAS bf16x8*)(lds + PG8_SA(b, h) + aoff + m * 2048 + k * 1024); } while (0)
#define PG8_LDB(dst, b, h) do { _Pragma("unroll") for (int n = 0; n < 2; ++n) _Pragma("unroll") for (int k = 0; k < 2; ++k) dst[n][k] = *(const PG8_LAS bf16x8*)(lds + PG8_SB(b, h) + boff + n * 2048 + k * 1024); } while (0)
#define PG8_MMA(ai, bj, At, Bt) do { __builtin_amdgcn_s_setprio(1); _Pragma("unroll") for (int m = 0; m < 4; ++m) _Pragma("unroll") for (int n = 0; n < 2; ++n) _Pragma("unroll") for (int k = 0; k < 2; ++k) \
        acc[ai][bj][m][n] = __builtin_amdgcn_mfma_f32_16x16x32_bf16(Bt[n][k], At[m][k], acc[ai][bj][m][n], 0, 0, 0); __builtin_amdgcn_s_setprio(0); } while (0)
#define PG8_WAIT_V(n) asm volatile("s_waitcnt vmcnt(" #n ")" ::: "memory")
#define PG8_WAIT_L(n) asm volatile("s_waitcnt lgkmcnt(" #n ")" ::: "memory")
#define PG8_BAR __builtin_amdgcn_s_barrier()
#define PG8_SCHED __builtin_amdgcn_sched_barrier(0)
    Unit cur, nxt; int ui = 0;
    if (!S.next(0, cur)) return;
    Acc acc;
#pragma unroll
    for (int a = 0; a < 2; ++a)
#pragma unroll
        for (int b = 0; b < 2; ++b)
#pragma unroll
            for (int m = 0; m < 4; ++m)
#pragma unroll
                for (int n = 0; n < 2; ++n) acc[a][b][m][n] = (f32x4){0.f, 0.f, 0.f, 0.f};
    bf16x8 At[4][2], B0[2][2], B1[2][2];
    const char* cA = PG8_UA(cur); const char* cB = PG8_UB(cur);
    PG8_STAGE(PG8_SB(0, 0), cB, voffB); PG8_STAGE(PG8_SB(0, 1), cB + hstepB, voffB); PG8_STAGE(PG8_SA(0, 0), cA, voffA); PG8_STAGE(PG8_SA(0, 1), cA + hstepA, voffA);
    if (wr == 1) PG8_BAR;
    PG8_WAIT_V(2); PG8_BAR;
    PG8_STAGE(PG8_SB(1, 0), cB + kstep, voffB); PG8_STAGE(PG8_SA(1, 0), cA + kstep, voffA); PG8_STAGE(PG8_SB(1, 1), cB + hstepB + kstep, voffB);
    PG8_WAIT_V(6); PG8_BAR;
    for (;;) {
        const bool has_next = S.next(ui + 1, nxt);
        const char* nA = has_next ? PG8_UA(nxt) : cA; const char* nB = has_next ? PG8_UB(nxt) : cB;
#pragma nounroll
        for (int t = 0; t < nt; t += 2) {
            if constexpr (Epi::MID) { if (t == (nt >> 1)) { int fr_ = fr, fq_ = fq; asm volatile("" : "+v"(fr_), "+v"(fq_)); E.mid(acc, cur, wr, wc, fr_, fq_); } }
            const bool last = (t == nt - 2);
            const char* a1 = cA + (size_t)(t + 1) * kstep;
            const char* a2 = last ? nA : cA + (size_t)(t + 2) * kstep; const char* b2 = last ? nB : cB + (size_t)(t + 2) * kstep;
            const char* a3 = a2 + kstep; const char* b3 = b2 + kstep;
            PG8_LDB(B0, 0, 0); PG8_LDB(B1, 0, 1); PG8_SCHED; PG8_LDA(At, 0, 0); PG8_STAGE(PG8_SA(1, 1), a1 + hstepA, voffA);
            PG8_WAIT_V(8); PG8_WAIT_L(0); PG8_BAR; PG8_MMA(0, 0, At, B0); PG8_MMA(0, 1, At, B1); PG8_BAR; PG8_SCHED;
            PG8_LDA(At, 0, 1); PG8_STAGE(PG8_SB(0, 0), b2, voffB); PG8_STAGE(PG8_SB(0, 1), b2 + hstepB, voffB); PG8_STAGE(PG8_SA(0, 0), a2, voffA);
            PG8_WAIT_V(8); PG8_WAIT_L(0); PG8_BAR; PG8_MMA(1, 0, At, B0); PG8_MMA(1, 1, At, B1); PG8_BAR; PG8_SCHED;
            PG8_LDB(B0, 1, 0); PG8_LDB(B1, 1, 1); PG8_SCHED; PG8_LDA(At, 1, 0); PG8_STAGE(PG8_SA(0, 1), a2 + hstepA, voffA);
            PG8_WAIT_V(8); PG8_WAIT_L(0); PG8_BAR; PG8_MMA(0, 0, At, B0); PG8_MMA(0, 1, At, B1); PG8_BAR; PG8_SCHED;
            PG8_LDA(At, 1, 1); PG8_STAGE(PG8_SB(1, 0), b3, voffB); PG8_STAGE(PG8_SB(1, 1), b3 + hstepB, voffB); PG8_STAGE(PG8_SA(1, 0), a3, voffA);
            PG8_WAIT_V(8); PG8_WAIT_L(0); PG8_BAR; PG8_MMA(1, 0, At, B0); PG8_MMA(1, 1, At, B1); PG8_BAR; PG8_SCHED;
        }
        if (wr == 0) PG8_BAR;
        asm volatile("" ::: "memory"); __builtin_amdgcn_sched_barrier(0);
        { int fr_ = fr, fq_ = fq; asm volatile("" : "+v"(fr_), "+v"(fq_)); E(acc, cur, wr, wc, fr_, fq_, ldsx); }
        if (!has_next) break;
#pragma unroll
        for (int a = 0; a < 2; ++a)
#pragma unroll
            for (int b = 0; b < 2; ++b)
#pragma unroll
                for (int m = 0; m < 4; ++m)
#pragma unroll
                    for (int n = 0; n < 2; ++n) acc[a][b][m][n] = (f32x4){0.f, 0.f, 0.f, 0.f};
        cur = nxt; cA = nA; cB = nB; ++ui;
        if (wr == 1) PG8_BAR;
    }
    PG8_WAIT_V(0);
    PG8_BAR;
#undef PG8_UA
#undef PG8_UB
#undef PG8_SA
#undef PG8_SB
#undef PG8_STAGE
#undef PG8_LDA
#undef PG8_LDB
#undef PG8_MMA
#undef PG8_WAIT_V
#undef PG8_WAIT_L
#undef PG8_BAR
#undef PG8_SCHED
}
}

using pg8::bf16_t; using pg8::f32x4; using pg8::f32x2; using pg8::u32x4; using pg8::u32x2;
#define LAS __attribute__((address_space(3)))
constexpr int MT = 8192, DM = 2048, SEQ = 4096, NIN = 10240, FF = 8192;
constexpr float DN_ALPHA = 1.189207115002721f, LN_EPS = 1e-5f;
constexpr size_t MiB = 1u << 20;
constexpr size_t WS_BAR = 65536, WS_BAR_BYTES = 16384;
constexpr size_t WS_KC = 0, WS_AGG = 296 * MiB;
constexpr size_t WS_WIN = 2 * MiB, WS_XB = 42 * MiB, WS_POOLT = 74 * MiB, WS_WG = 76 * MiB, WS_WUP = 80 * MiB, WS_WOUT = 96 * MiB;
constexpr size_t WS_Z = 104 * MiB;
constexpr size_t WS_UP = WS_Z, WS_UL = WS_Z + 32 * MiB, WS_GG = WS_Z + 64 * MiB, WS_GA = WS_Z + 96 * MiB, WS_GB = WS_Z + 128 * MiB;
constexpr size_t WS_D = 264 * MiB, WS_XC = 34 * MiB, WS_W1 = 2 * MiB;
constexpr size_t WS_YY = 104 * MiB, WS_MB = 264 * MiB, WS_V1 = 168 * MiB;
constexpr size_t WS_X1 = 232 * MiB, WS_X1B = 34 * MiB, WS_W2 = 66 * MiB, WS_H = 104 * MiB, WS_V2 = 2 * MiB;
constexpr size_t WS_END = 320 * MiB;
constexpr int LDS_BYTES = 147456, LDS_MISC = 131072 + 12288;
constexpr int NPHASE = 11;


#define XB_TMO      128
#define XB_XCNT(j)  (256  + 64 * (j))
#define XB_XSUB(j)  (1280 + 64 * (j))
#define XB_XGEN(j)  (2304 + 64 * (j))
#define XB_TOP      3328
#define XB_TOPGEN   3392
#define XCD_BAR_WORDS 3456
#define XB_SPIN_CAP (1u << 18)
__device__ __forceinline__ unsigned xb_ld(unsigned* p)              { return __hip_atomic_load(p, __ATOMIC_RELAXED, __HIP_MEMORY_SCOPE_AGENT); }
__device__ __forceinline__ unsigned xb_add(unsigned* p, unsigned v) { return __hip_atomic_fetch_add(p, v, __ATOMIC_RELAXED, __HIP_MEMORY_SCOPE_AGENT); }
__device__ __forceinline__ unsigned xb_xcc_id() { return (unsigned)__builtin_amdgcn_s_getreg((3 << 11) | 20) & 0xFu; }
#define XB_SPIN(cond, bar) do { unsigned _sp = 0; while (cond) { __builtin_amdgcn_s_sleep(1); \
    if ((++_sp & 255u) == 0u) { if (xb_ld(&(bar)[XB_TMO])) break; if (_sp > XB_SPIN_CAP) { atomicAdd(&(bar)[XB_TMO], 1u); break; } } } } while (0)
struct XcdBarrier { unsigned* bar; unsigned x; volatile LAS unsigned* st; };
__device__ __forceinline__ XcdBarrier xcd_barrier_post(unsigned* bar, volatile LAS unsigned* st) {
    XcdBarrier b; b.bar = bar; b.x = xb_xcc_id(); b.st = st;
    if (threadIdx.x == 0) (void)xb_add(&bar[XB_XCNT(b.x)], 1u);
    return b;
}
__device__ __forceinline__ void xcd_barrier_complete(unsigned* bar, unsigned x, unsigned& nloc, unsigned& nx) {
    const unsigned G = gridDim.x * gridDim.y * gridDim.z;
    unsigned sum, cnt, mine, sp = 0u;
    for (;;) {
        sum = 0u; cnt = 0u; mine = 0u;
#pragma unroll
        for (unsigned j = 0; j < 16; ++j) { const unsigned c = xb_ld(&bar[XB_XCNT(j)]); sum += c; cnt += (c > 0u) ? 1u : 0u; mine = (j == x) ? c : mine; }
        if (sum == G) break;
        __builtin_amdgcn_s_sleep(1);
        if ((++sp & 255u) == 0u) { if (xb_ld(&bar[XB_TMO])) break; if (sp > XB_SPIN_CAP) { atomicAdd(&bar[XB_TMO], 1u); break; } }
    }
    nloc = mine > 0u ? mine : 1u; nx = cnt > 0u ? cnt : 1u;
}
__device__ __forceinline__ void xcd_barrier(const XcdBarrier& b) {
    asm volatile("s_waitcnt vmcnt(0)" ::: "memory");
    __syncthreads();
    if (threadIdx.x == 0) {
        unsigned* bar = b.bar;
        __builtin_amdgcn_s_waitcnt(0);
        unsigned nloc = b.st[0], nx = b.st[1];
        if (nloc == 0u) { xcd_barrier_complete(bar, b.x, nloc, nx); b.st[0] = nloc; b.st[1] = nx; }
        const unsigned old = xb_add(&bar[XB_XSUB(b.x)], 1u);
        const unsigned gen = old / nloc;
        if (old + 1u == (gen + 1u) * nloc) {
            __builtin_amdgcn_fence(__ATOMIC_RELEASE, "agent");
            asm volatile("s_waitcnt vmcnt(0)" ::: "memory");
            const unsigned og = xb_add(&bar[XB_TOP], 1u);
            const unsigned tg = og / nx;
            if (og + 1u == (tg + 1u) * nx) xb_add(&bar[XB_TOPGEN], 1u);
            else XB_SPIN(xb_ld(&bar[XB_TOPGEN]) == tg, bar);
            __builtin_amdgcn_fence(__ATOMIC_ACQUIRE, "agent");
            xb_add(&bar[XB_XGEN(b.x)], 1u);
            asm volatile("s_waitcnt vmcnt(0)" ::: "memory");
        } else {
            XB_SPIN(xb_ld(&bar[XB_XGEN(b.x)]) == gen, bar);
            __builtin_amdgcn_fence(__ATOMIC_ACQUIRE, "agent");
            asm volatile("s_waitcnt vmcnt(0)" ::: "memory");
        }
    }
    __syncthreads();
}

__device__ __forceinline__ float wave_sum(float v) {
#pragma unroll
    for (int o = 1; o < 64; o <<= 1) v += __shfl_xor(v, o);
    return v;
}
__device__ __forceinline__ void transpose_item(const float* S, int lds_, bf16_t* Dst, int ldd, int k0, int n0, int mode, int dgoff, LAS float* scr, int lane) {
    {
        const int kr = lane >> 4, nc = (lane & 15) * 4;
        const float* sp = S + (size_t)(k0 + kr) * lds_ + n0 + nc;
#pragma unroll
        for (int i = 0; i < 16; ++i) { const f32x4 v = *(const f32x4*)(sp + (size_t)(4 * i) * lds_); LAS float* d = scr + (4 * i + kr) * 65 + nc; d[0] = v[0]; d[1] = v[1]; d[2] = v[2]; d[3] = v[3]; }
    }
    asm volatile("s_waitcnt lgkmcnt(0)" ::: "memory");
#pragma unroll
    for (int j = 0; j < 8; ++j) {
        const int q = j * 64 + lane, n = q >> 3, c = q & 7;
        const LAS float* s = scr + (8 * c) * 65 + n;
        u32x4 o; o.x = pg8::cvt_pk_bf16(s[0], s[65]); o.y = pg8::cvt_pk_bf16(s[130], s[195]); o.z = pg8::cvt_pk_bf16(s[260], s[325]); o.w = pg8::cvt_pk_bf16(s[390], s[455]);
        const int nn = n0 + n;
        const int row = mode == 0 ? nn : ((nn >> 6) * 256 + dgoff + ((nn & 63) >> 4) * 32 + (nn & 15));
        *(u32x4*)(Dst + (size_t)row * ldd + k0 + 8 * c) = o;
    }
    asm volatile("s_waitcnt lgkmcnt(0)" ::: "memory");
}
__device__ __forceinline__ void transpose_matrix(const float* S, int K, int N, bf16_t* Dst, int ldd, int it, LAS float* scr, int lane) {
    const int nblk = N >> 6, kb = it / nblk, nb = it % nblk;
    transpose_item(S, N, Dst, ldd, kb * 64, nb * 64, 0, 0, scr, lane);
}

struct Args {
    const float *x, *w_in, *pool_w, *pool_scale, *conv_w, *conv_b, *lru_wa, *lru_ba, *lru_wx, *lru_bx, *lru_lambda, *w_pool_up, *w_lru_up, *w_out, *b_out,
        *ln1_g, *ln1_b, *w_ff1, *b_ff1, *w_ff2, *b_ff2, *ln2_g, *ln2_b;
    float* out; unsigned char* ws; int ph_lo, ph_hi;
};

__device__ __forceinline__ void ln_rows(const float* V, const float* g, const float* b, float* outf, bf16_t* outb, int gw, int NGW, int lane) {
    for (int row = gw; row < MT; row += NGW) {
        const f32x4* vr = (const f32x4*)(V + (size_t)row * DM) + lane;
        f32x4 v[8]; float s = 0.f;
#pragma unroll
        for (int j = 0; j < 8; ++j) { v[j] = vr[64 * j]; s += (v[j][0] + v[j][1]) + (v[j][2] + v[j][3]); }
        const float mean = wave_sum(s) * (1.f / DM); float s2 = 0.f;
#pragma unroll
        for (int j = 0; j < 8; ++j) { v[j] = v[j] - mean; s2 += (v[j][0] * v[j][0] + v[j][1] * v[j][1]) + (v[j][2] * v[j][2] + v[j][3] * v[j][3]); }
        const float rstd = 1.0f / sqrtf(wave_sum(s2) * (1.f / DM) + LN_EPS);
#pragma unroll
        for (int j = 0; j < 8; ++j) {
            const f32x4 gg = *((const f32x4*)g + lane + 64 * j), bb = *((const f32x4*)b + lane + 64 * j);
            const f32x4 y = v[j] * rstd * gg + bb;
            *((f32x4*)(outf + (size_t)row * DM) + lane + 64 * j) = y;
            if (outb) { u32x2 w; w.x = pg8::cvt_pk_bf16(y[0], y[1]); w.y = pg8::cvt_pk_bf16(y[2], y[3]); *((u32x2*)(outb + (size_t)row * DM) + lane + 64 * j) = w; }
        }
    }
}

__global__ void __launch_bounds__(512, 2) fwd_kernel(Args a) {
    extern __shared__ __attribute__((aligned(16))) unsigned char lds_raw[];
    LAS unsigned char* lds = (LAS unsigned char*)lds_raw;
    const int G = gridDim.x, bx = blockIdx.x;
#define THREAD_IDS() int tid = threadIdx.x; asm volatile("" : "+v"(tid)); const int lane = tid & 63, wave = __builtin_amdgcn_readfirstlane(tid >> 6); \
    const int gw = bx * 8 + wave, NGW = G * 8, gt = bx * 512 + tid, NT = G * 512; LAS float* scr = (LAS float*)(lds + wave * 16640); (void)lane; (void)gw; (void)NGW; (void)gt; (void)NT; (void)scr
#define KARGS() const __attribute__((address_space(4))) Args* ka = (const __attribute__((address_space(4))) Args*)__builtin_amdgcn_kernarg_segment_ptr(); asm volatile("" : "+s"(ka))
    int lo, hi; unsigned char* ws;
    { KARGS(); lo = ka->ph_lo; hi = ka->ph_hi; ws = ka->ws; }
    bf16_t* WinT = (bf16_t*)(ws + WS_WIN); bf16_t* XB = (bf16_t*)(ws + WS_XB); bf16_t* PoolT = (bf16_t*)(ws + WS_POOLT); bf16_t* WgT = (bf16_t*)(ws + WS_WG);
    bf16_t* WupT = (bf16_t*)(ws + WS_WUP); bf16_t* WoutT = (bf16_t*)(ws + WS_WOUT); bf16_t* W1T = (bf16_t*)(ws + WS_W1); bf16_t* W2T = (bf16_t*)(ws + WS_W2);
    bf16_t* Z0 = (bf16_t*)(ws + WS_Z); bf16_t* UP = (bf16_t*)(ws + WS_UP); bf16_t* UL = (bf16_t*)(ws + WS_UL); bf16_t* GGb = (bf16_t*)(ws + WS_GG);
    bf16_t* GAb = (bf16_t*)(ws + WS_GA); bf16_t* GBb = (bf16_t*)(ws + WS_GB);
    bf16_t* Db = (bf16_t*)(ws + WS_D); bf16_t* XCb = (bf16_t*)(ws + WS_XC); bf16_t* YY = (bf16_t*)(ws + WS_YY); bf16_t* Mb = (bf16_t*)(ws + WS_MB);
    float* V1 = (float*)(ws + WS_V1); float* X1 = (float*)(ws + WS_X1); bf16_t* X1B = (bf16_t*)(ws + WS_X1B); bf16_t* Hb = (bf16_t*)(ws + WS_H); float* V2 = (float*)(ws + WS_V2);
    float* KC = (float*)(ws + WS_KC); f32x2* AGG = (f32x2*)(ws + WS_AGG);
    if (lo < 0) cg::this_grid().sync();
    volatile LAS unsigned* misc = (volatile LAS unsigned*)(lds + LDS_MISC);
    if (threadIdx.x < 2) misc[threadIdx.x] = 0u;
    __syncthreads();
    const XcdBarrier gbar = xcd_barrier_post((unsigned*)(ws + WS_BAR), misc);
#ifndef PH_MASK
#define PH_MASK 0x7ff
#endif
#define IN(k) (((PH_MASK >> (k)) & 1) && lo <= (k) && (k) < hi)
#define SEAM(k) do { if (IN(k) && IN((k) + 1)) xcd_barrier(gbar); } while (0)

    if (IN(0)) { KARGS();
        THREAD_IDS();
        constexpr int I_IN = 32 * 160, I_POOL = 4 * 64, I_G = 32 * 16, I_UP = 1024, I_OUT = 1024;
        constexpr int NITEMS = I_IN + I_POOL + I_G + 2 * I_UP + I_OUT;
        for (int it = gw; it < NITEMS; it += NGW) {
            int r = it;
            if (r < I_IN) { transpose_matrix(ka->w_in, DM, NIN, WinT, DM, r, scr, lane); continue; } r -= I_IN;
            if (r < I_POOL) { const int g = r >> 6; transpose_matrix(ka->pool_w + (size_t)g * 512 * 512, 512, 512, PoolT + (size_t)g * 512 * 512, 512, r & 63, scr, lane); continue; } r -= I_POOL;
            if (r < I_G) { const int mat = r >> 4, sub = r & 15, h = mat & 7, gate = (mat >> 3) & 1, dir = mat >> 4;
                const float* S = (gate ? ka->lru_wx : ka->lru_wa) + (size_t)(dir * 8 + h) * 256 * 256;
                transpose_item(S, 256, WgT + (size_t)h * 4 * 256 * 256, 256, (sub >> 2) * 64, (sub & 3) * 64, 1, 128 * dir + 16 * gate, scr, lane); continue; } r -= I_G;
            if (r < I_UP) { transpose_matrix(ka->w_pool_up, DM, DM, WupT, 2 * DM, r, scr, lane); continue; } r -= I_UP;
            if (r < I_UP) { transpose_matrix(ka->w_lru_up, DM, DM, WupT + DM, 2 * DM, r, scr, lane); continue; } r -= I_UP;
            transpose_matrix(ka->w_out, DM, DM, WoutT, DM, r, scr, lane);
        }
        for (int i = gt; i < MT * DM / 8; i += NT) {
            const f32x4 v0 = *((const f32x4*)ka->x + 2 * (size_t)i), v1 = *((const f32x4*)ka->x + 2 * (size_t)i + 1);
            u32x4 w; w.x = pg8::cvt_pk_bf16(v0[0], v0[1]); w.y = pg8::cvt_pk_bf16(v0[2], v0[3]); w.z = pg8::cvt_pk_bf16(v1[0], v1[1]); w.w = pg8::cvt_pk_bf16(v1[2], v1[3]);
            *((u32x4*)XB + i) = w;
        }
        if (gt < 2 * DM) KC[gt] = -8.0f * 1.44269504f * log1pf(expf(-ka->lru_lambda[gt]));
    }
    SEAM(0);
    if (IN(1)) { KARGS();
        pg8::Gemm g{XB, WinT, DM, DM, DM / 64, 1, 0}; pg8::StaticOrder S; S.init(32, NIN / 256, G, bx);
        pg8::EpiZ E{Z0};
        pg8::gemm_phase<pg8::EpiZ>(lds, g, S, E);
    }
    SEAM(1);
    if (IN(2)) { KARGS();
        THREAD_IDS();
        for (int item = gt; item < 512 * 512; item += NT) {
            const int chunk = item & 511, run = item >> 9;
            const int row0 = run * 16, t0 = row0 & (SEQ - 1), rowb = row0 - t0;
            if (chunk < 256) {
                const int c0 = chunk * 8, h = 1 << (chunk >> 6);
                const bf16_t* U = UP + (size_t)rowb * DM + c0;
                float sum[8];
#pragma unroll
                for (int e = 0; e < 8; ++e) sum[e] = 0.f;
                for (int s = t0 - h; s < t0 + h; ++s) if (s >= 0 && s < SEQ) { const u32x4 w = *(const u32x4*)(U + (size_t)s * DM);
                    sum[0] += pg8::bf_lo(w.x); sum[1] += pg8::bf_hi(w.x); sum[2] += pg8::bf_lo(w.y); sum[3] += pg8::bf_hi(w.y); sum[4] += pg8::bf_lo(w.z); sum[5] += pg8::bf_hi(w.z); sum[6] += pg8::bf_lo(w.w); sum[7] += pg8::bf_hi(w.w); }
                const u32x4 zz = (u32x4){0u, 0u, 0u, 0u};
#define ACC8(sg, q) do { sum[0] sg pg8::bf_lo(q.x); sum[1] sg pg8::bf_hi(q.x); sum[2] sg pg8::bf_lo(q.y); sum[3] sg pg8::bf_hi(q.y); sum[4] sg pg8::bf_lo(q.z); sum[5] sg pg8::bf_hi(q.z); sum[6] sg pg8::bf_lo(q.w); sum[7] sg pg8::bf_hi(q.w); } while (0)
                for (int i0 = 0; i0 < 16; i0 += 4) {
                    u32x4 wt[4], qa[4], qs[4];
#pragma unroll
                    for (int j = 0; j < 4; ++j) { const int t = t0 + i0 + j;
                        wt[j] = *(const u32x4*)(U + (size_t)t * DM);
                        qa[j] = (t + h < SEQ) ? *(const u32x4*)(U + (size_t)(t + h) * DM) : zz;
                        qs[j] = (t - h >= 0) ? *(const u32x4*)(U + (size_t)(t - h) * DM) : zz; }
#pragma unroll
                    for (int j = 0; j < 4; ++j) { const int t = t0 + i0 + j; const int lo_ = t - h < 0 ? 0 : t - h, hi_ = t + h > SEQ ? SEQ : t + h;
                        const float inv = 1.0f / (float)(hi_ - lo_);
                        const u32x4 w = wt[j];
                        u32x4 o;
                        o.x = pg8::cvt_pk_bf16(sum[0] * inv - pg8::bf_lo(w.x), sum[1] * inv - pg8::bf_hi(w.x)); o.y = pg8::cvt_pk_bf16(sum[2] * inv - pg8::bf_lo(w.y), sum[3] * inv - pg8::bf_hi(w.y));
                        o.z = pg8::cvt_pk_bf16(sum[4] * inv - pg8::bf_lo(w.z), sum[5] * inv - pg8::bf_hi(w.z)); o.w = pg8::cvt_pk_bf16(sum[6] * inv - pg8::bf_lo(w.w), sum[7] * inv - pg8::bf_hi(w.w));
                        *(u32x4*)(Db + (size_t)(rowb + t) * DM + c0) = o;
                        ACC8(+=, qa[j]); ACC8(-=, qs[j]); }
                }
#undef ACC8
            } else {
                const int c0 = (chunk - 256) * 8;
                const bf16_t* U = UL + (size_t)rowb * DM + c0;
                f32x4 w0[4], w1[4];
#pragma unroll
                for (int k = 0; k < 4; ++k) { w0[k] = *(const f32x4*)(ka->conv_w + k * DM + c0); w1[k] = *(const f32x4*)(ka->conv_w + k * DM + c0 + 4); }
                const f32x4 b0 = *(const f32x4*)(ka->conv_b + c0), b1 = *(const f32x4*)(ka->conv_b + c0 + 4);
                const u32x4 zz = (u32x4){0u, 0u, 0u, 0u};
                u32x4 r0 = (t0 - 2 >= 0) ? *(const u32x4*)(U + (size_t)(t0 - 2) * DM) : zz;
                u32x4 r1 = (t0 - 1 >= 0) ? *(const u32x4*)(U + (size_t)(t0 - 1) * DM) : zz;
                u32x4 r2 = *(const u32x4*)(U + (size_t)t0 * DM);
                for (int i0 = 0; i0 < 16; i0 += 4) {
                    u32x4 rn[4];
#pragma unroll
                    for (int j = 0; j < 4; ++j) { const int t = t0 + i0 + j; rn[j] = (t + 1 < SEQ) ? *(const u32x4*)(U + (size_t)(t + 1) * DM) : zz; }
#pragma unroll
                    for (int j = 0; j < 4; ++j) { const int t = t0 + i0 + j;
                        const u32x4 r3 = rn[j];
                        f32x4 y0 = b0, y1 = b1;
#define CONV_TAP(rk, k) do { y0 += (f32x4){pg8::bf_lo(rk.x), pg8::bf_hi(rk.x), pg8::bf_lo(rk.y), pg8::bf_hi(rk.y)} * w0[k]; y1 += (f32x4){pg8::bf_lo(rk.z), pg8::bf_hi(rk.z), pg8::bf_lo(rk.w), pg8::bf_hi(rk.w)} * w1[k]; } while (0)
                        CONV_TAP(r0, 0); CONV_TAP(r1, 1); CONV_TAP(r2, 2); CONV_TAP(r3, 3);
#undef CONV_TAP
                        u32x4 o; o.x = pg8::cvt_pk_bf16(y0[0], y0[1]); o.y = pg8::cvt_pk_bf16(y0[2], y0[3]); o.z = pg8::cvt_pk_bf16(y1[0], y1[1]); o.w = pg8::cvt_pk_bf16(y1[2], y1[3]);
                        *(u32x4*)(XCb + (size_t)(rowb + t) * DM + c0) = o;
                        r0 = r1; r1 = r2; r2 = r3; }
                }
            }
        }
        for (int it = gw; it < 32 * 128; it += NGW) transpose_matrix(ka->w_ff1, DM, FF, W1T, DM, it, scr, lane);
    }
    SEAM(2);
    if (IN(3)) { KARGS();
        { pg8::Gemm g{Db, PoolT, DM, 512, 8, 2, 512}; pg8::StaticOrder S; S.init(32, 8, G, bx);
          pg8::EpiB<0> E{YY, 2 * DM, ka->pool_scale};
          pg8::gemm_phase<pg8::EpiB<0>>(lds, g, S, E); }
        { pg8::Gemm g{XCb, WgT, DM, 256, 4, 4, 256}; pg8::StaticOrder S; S.init(32, 32, G, bx);
          pg8::EpiGate<1> E{XCb, GGb, YY, ka->lru_ba, ka->lru_bx, KC, AGG};
          pg8::gemm_phase<pg8::EpiGate<1>>(lds, g, S, E); }
    }
    SEAM(3);
    if (IN(4)) { KARGS();
        pg8::Gemm g{XCb, WgT, DM, 256, 4, 4, 256}; pg8::StaticOrder S; S.init(32, 32, G, bx);
        pg8::EpiGate<2> E{XCb, GGb, YY, ka->lru_ba, ka->lru_bx, KC, AGG};
        pg8::gemm_phase<pg8::EpiGate<2>>(lds, g, S, E);
    }
    SEAM(4);
    if (IN(5)) { KARGS();
        pg8::Gemm g{YY, WupT, 2 * DM, 2 * DM, 2 * DM / 64, 1, 0}; pg8::StaticOrder S; S.init(32, 8, G, bx);
        pg8::EpiMerge E{GAb, GBb, Mb};
        pg8::gemm_phase<pg8::EpiMerge>(lds, g, S, E);
    }
    SEAM(5);
    if (IN(6)) { KARGS();
        pg8::Gemm g{Mb, WoutT, DM, DM, DM / 64, 1, 0}; pg8::StaticOrder S; S.init(32, 8, G, bx);
        pg8::EpiRes E{ka->x, V1, ka->b_out, DN_ALPHA};
        pg8::gemm_phase<pg8::EpiRes>(lds, g, S, E);
    }
    SEAM(6);
    if (IN(7)) { KARGS();
        THREAD_IDS();
        ln_rows(V1, ka->ln1_g, ka->ln1_b, X1, X1B, gw, NGW, lane);
        for (int it = gw; it < 128 * 32; it += NGW) transpose_matrix(ka->w_ff2, FF, DM, W2T, FF, it, scr, lane);
    }
    SEAM(7);
    if (IN(8)) { KARGS();
        pg8::Gemm g{X1B, W1T, DM, DM, DM / 64, 1, 0}; pg8::StaticOrder S; S.init(32, FF / 256, G, bx);
        pg8::EpiB<1> E{Hb, FF, ka->b_ff1};
        pg8::gemm_phase<pg8::EpiB<1>>(lds, g, S, E);
    }
    SEAM(8);
    if (IN(9)) { KARGS();
        pg8::Gemm g{Hb, W2T, FF, FF, FF / 64, 1, 0}; pg8::StaticOrder S; S.init(32, 8, G, bx);
        pg8::EpiRes E{X1, V2, ka->b_ff2, DN_ALPHA};
        pg8::gemm_phase<pg8::EpiRes>(lds, g, S, E);
    }
    SEAM(9);
    if (IN(10)) { KARGS(); THREAD_IDS(); ln_rows(V2, ka->ln2_g, ka->ln2_b, ka->out, nullptr, gw, NGW, lane); }
#undef IN
#undef SEAM
}

extern "C" void kernel_launch(void* const* d_in, const int* in_sizes, int n_in, void* d_out, int out_size, void* d_ws, size_t ws_size, hipStream_t stream) {
    static int grid = 0;
    if (grid == 0) {
        if (n_in != 23 || in_sizes[0] != MT * DM || out_size != MT * DM || ws_size < WS_END) { fprintf(stderr, "kernel_launch: unexpected shapes (n_in %d, ws %zu)\n", n_in, ws_size); grid = -1; return; }
        int dev = 0, cus = 0, per_cu = 0;
        hipGetDevice(&dev); hipDeviceGetAttribute(&cus, hipDeviceAttributeMultiprocessorCount, dev);
        if (hipFuncSetAttribute((const void*)fwd_kernel, hipFuncAttributeMaxDynamicSharedMemorySize, LDS_BYTES) != hipSuccess) { fprintf(stderr, "kernel_launch: hipFuncSetAttribute failed\n"); grid = -1; return; }
        hipOccupancyMaxActiveBlocksPerMultiprocessor(&per_cu, (const void*)fwd_kernel, 512, LDS_BYTES);
        (void)hipGetLastError();
        if (per_cu < 1) per_cu = 1;
        grid = cus * per_cu;
        if (grid > 256) grid = 256;
    }
    if (grid < 0) return;
    if (hipMemsetAsync((char*)d_ws + WS_BAR, 0, WS_BAR_BYTES, stream) != hipSuccess) { fprintf(stderr, "kernel_launch: memset failed\n"); return; }
    Args a{};
    const float** ap = (const float**)&a;
    for (int i = 0; i < 23; ++i) ap[i] = (const float*)d_in[i];
    a.out = (float*)d_out; a.ws = (unsigned char*)d_ws;
#if MK_N_LAUNCHES == 1
    a.ph_lo = 0; a.ph_hi = NPHASE;
    void* args[] = {&a};
    hipError_t e = hipLaunchCooperativeKernel((const void*)fwd_kernel, dim3(grid), dim3(512), args, LDS_BYTES, stream);
    if (e != hipSuccess) fprintf(stderr, "cooperative launch failed: %s (grid %d)\n", hipGetErrorString(e), grid);
#ifdef PROBE_MASK
    for (int p = 0; p < NPHASE; ++p) if ((PROBE_MASK >> p) & 1) { a.ph_lo = p; a.ph_hi = p + 1; hipLaunchKernelGGL(fwd_kernel, dim3(grid), dim3(512), LDS_BYTES, stream, a); }
#endif
#else
    for (int p = 0; p < NPHASE; ++p) { a.ph_lo = p; a.ph_hi = p + 1; hipLaunchKernelGGL(fwd_kernel, dim3(grid), dim3(512), LDS_BYTES, stream, a); }
#endif
}
```
